# Optimizing an MI355X kernel written in HIP

```python
import math
import jax, jax.numpy as jnp
from jax import lax
import numpy as np

D_MODEL = 1024
BATCH = 4
SEQ = 4096
DEPTH = 2

HEAD_DIM = 64
BLOCK = 128
WINDOW = 128
A_Q_HEADS = 8
A_KV_HEADS = 2
A_GROUP = A_Q_HEADS // A_KV_HEADS
B_HEADS = 4
B_V_DIM = 2 * HEAD_DIM
D_FF = 2816
RMS_EPS = 1e-6
NEG_INF = -1e30

A_Q_COLS = A_Q_HEADS * HEAD_DIM
A_KV_COLS = A_KV_HEADS * HEAD_DIM
B_QK_COLS = B_HEADS * 2 * HEAD_DIM
B_V_COLS = B_HEADS * B_V_DIM
IN_COLS = A_Q_COLS + 2 * A_KV_COLS + 2 * B_QK_COLS + B_V_COLS
MIX_WIDTH = A_Q_COLS + B_V_COLS
SPLITS = list(np.cumsum([A_Q_COLS, A_KV_COLS, A_KV_COLS, B_QK_COLS, B_QK_COLS]))

kernel_name = "hybrid_swa_sink_diffattn_alibi_macaron"


def alibi_slopes(n):
    return jnp.exp2(-8.0 * jnp.arange(1, n + 1, dtype=jnp.float32) / n)


def rms_norm(x, g):
    xf = x.astype(jnp.float32)
    y = xf * lax.rsqrt(jnp.mean(xf * xf, axis=-1, keepdims=True) + RMS_EPS)
    return (y * g.astype(jnp.float32)).astype(x.dtype)


def swiglu(h, w_gate, w_up, w_down):
    return (jax.nn.silu(h @ w_gate) * (h @ w_up)) @ w_down


def windowed_gqa_sink(q, k, v, sink, slopes):
    b, s, _, dh = q.shape
    nb = s // BLOCK
    qb = q.reshape(b, nb, BLOCK, A_KV_HEADS, A_GROUP, dh)
    pad = ((0, 0), (BLOCK, BLOCK), (0, 0), (0, 0))
    kp = jnp.pad(k, pad)
    vp = jnp.pad(v, pad)
    key_idx = jnp.arange(nb)[:, None] * BLOCK + jnp.arange(3 * BLOCK)[None, :]
    kb = kp[:, key_idx]
    vb = vp[:, key_idx]
    scores = jnp.einsum('bnqkgd,bnjkd->bnkgqj', qb, kb).astype(jnp.float32) * (dh ** -0.5)
    q_pos = jnp.arange(nb)[:, None] * BLOCK + jnp.arange(BLOCK)[None, :]
    k_pos = key_idx - BLOCK
    dist = jnp.abs(q_pos[:, :, None] - k_pos[:, None, :])
    valid = (dist <= WINDOW) & (k_pos[:, None, :] >= 0) & (k_pos[:, None, :] < s)
    bias = -slopes.reshape(A_KV_HEADS, A_GROUP)[None, :, :, None, None] * dist[:, None, None].astype(jnp.float32)
    scores = jnp.where(valid[:, None, None], scores + bias, NEG_INF)
    sink_l = sink.astype(jnp.float32).reshape(1, 1, A_KV_HEADS, A_GROUP, 1, 1)
    m = jnp.maximum(jnp.max(scores, axis=-1, keepdims=True), sink_l)
    e = jnp.exp(scores - m)
    p = e / (jnp.sum(e, axis=-1, keepdims=True) + jnp.exp(sink_l - m))
    out = jnp.einsum('bnkgqj,bnjkd->bnqkgd', p.astype(v.dtype), vb)
    return out.reshape(b, s, A_Q_HEADS * dh)


def differential_attention(q, k, v, lam, slopes):
    b, s, h, _, dh = q.shape
    nb = s // BLOCK
    q_blocks = jnp.moveaxis(q.reshape(b, nb, BLOCK, h, 2, dh), 1, 0)
    starts = jnp.arange(nb) * BLOCK
    key_pos = jnp.arange(s)
    scale = dh ** -0.5

    def one_block(args):
        qi, start = args
        sc = jnp.einsum('bqhcd,bkhcd->bhcqk', qi, k).astype(jnp.float32) * scale
        dist = jnp.abs((start + jnp.arange(BLOCK))[:, None] - key_pos[None, :]).astype(jnp.float32)
        sc = sc - slopes[:, None, None, None] * dist
        p = jax.nn.softmax(sc, axis=-1)
        a = p[:, :, 0] - lam * p[:, :, 1]
        return jnp.einsum('bhqk,bkhe->bqhe', a.astype(v.dtype), v)

    out = lax.map(one_block, (q_blocks, starts))
    return jnp.moveaxis(out, 0, 1).reshape(b, s, h, -1)


def setup_inputs(seed: int = 0) -> dict:
    key = jax.random.key(seed)
    ks = jax.random.split(key, 24)
    f32 = jnp.float32

    def nrm(k, shape, scale):
        return jax.random.normal(k, shape, f32) * scale

    def gain(k, shape):
        return 1.0 + 0.02 * jax.random.normal(k, shape, f32)

    return {
        "x": jax.random.normal(ks[0], (BATCH, SEQ, D_MODEL), f32),
        "ffn1_norm": gain(ks[1], (DEPTH, D_MODEL)),
        "ffn1_w_gate": nrm(ks[2], (DEPTH, D_MODEL, D_FF), D_MODEL ** -0.5),
        "ffn1_w_up": nrm(ks[3], (DEPTH, D_MODEL, D_FF), D_MODEL ** -0.5),
        "ffn1_w_down": nrm(ks[4], (DEPTH, D_FF, D_MODEL), D_FF ** -0.5),
        "mix_norm": gain(ks[5], (DEPTH, D_MODEL)),
        "w_in": nrm(ks[6], (DEPTH, D_MODEL, IN_COLS), D_MODEL ** -0.5),
        "sink": nrm(ks[7], (DEPTH, A_Q_HEADS), 0.5),
        "lam_q1": nrm(ks[8], (DEPTH, HEAD_DIM), 0.1),
        "lam_k1": nrm(ks[9], (DEPTH, HEAD_DIM), 0.1),
        "lam_q2": nrm(ks[10], (DEPTH, HEAD_DIM), 0.1),
        "lam_k2": nrm(ks[11], (DEPTH, HEAD_DIM), 0.1),
        "diff_subln": gain(ks[12], (DEPTH, B_V_DIM)),
        "w_out": nrm(ks[13], (DEPTH, MIX_WIDTH, D_MODEL), MIX_WIDTH ** -0.5),
        "ffn2_norm": gain(ks[14], (DEPTH, D_MODEL)),
        "ffn2_w_gate": nrm(ks[15], (DEPTH, D_MODEL, D_FF), D_MODEL ** -0.5),
        "ffn2_w_up": nrm(ks[16], (DEPTH, D_MODEL, D_FF), D_MODEL ** -0.5),
        "ffn2_w_down": nrm(ks[17], (DEPTH, D_FF, D_MODEL), D_FF ** -0.5),
        "final_norm": gain(ks[18], (D_MODEL,)),
    }


def reference(x, ffn1_norm, ffn1_w_gate, ffn1_w_up, ffn1_w_down, mix_norm, w_in, sink,
              lam_q1, lam_k1, lam_q2, lam_k2, diff_subln, w_out,
              ffn2_norm, ffn2_w_gate, ffn2_w_up, ffn2_w_down, final_norm):
    b, s, _ = x.shape
    slopes_a = alibi_slopes(A_Q_HEADS)
    slopes_b = alibi_slopes(B_HEADS)
    for l in range(DEPTH):
        x = x + 0.5 * swiglu(rms_norm(x, ffn1_norm[l]), ffn1_w_gate[l], ffn1_w_up[l], ffn1_w_down[l])

        h = rms_norm(x, mix_norm[l])
        proj = h @ w_in[l]
        qa, ka, va, qb, kb, vb = jnp.split(proj, SPLITS, axis=-1)
        qa = qa.reshape(b, s, A_Q_HEADS, HEAD_DIM)
        ka = ka.reshape(b, s, A_KV_HEADS, HEAD_DIM)
        va = va.reshape(b, s, A_KV_HEADS, HEAD_DIM)
        qb = qb.reshape(b, s, B_HEADS, 2, HEAD_DIM)
        kb = kb.reshape(b, s, B_HEADS, 2, HEAD_DIM)
        vb = vb.reshape(b, s, B_HEADS, B_V_DIM)

        out_a = windowed_gqa_sink(qa, ka, va, sink[l], slopes_a)

        lam_init = 0.8 - 0.6 * math.exp(-0.3 * l)
        lam = (jnp.exp(jnp.sum(lam_q1[l].astype(jnp.float32) * lam_k1[l].astype(jnp.float32)))
               - jnp.exp(jnp.sum(lam_q2[l].astype(jnp.float32) * lam_k2[l].astype(jnp.float32)))
               + lam_init)
        out_b = differential_attention(qb, kb, vb, lam, slopes_b)
        out_b = (rms_norm(out_b, diff_subln[l]) * (1.0 - lam_init)).reshape(b, s, B_V_COLS)

        x = x + jnp.concatenate([out_a, out_b], axis=-1) @ w_out[l]

        x = x + 0.5 * swiglu(rms_norm(x, ffn2_norm[l]), ffn2_w_gate[l], ffn2_w_up[l], ffn2_w_down[l])
    return rms_norm(x, final_norm)
```

```cpp
#include <hip/hip_runtime.h>
#include <hip/hip_cooperative_groups.h>
#include <cstdio>
#include <cstdint>
namespace cg = cooperative_groups;
namespace pg8 {
#define PG8_LAS __attribute__((address_space(3)))
typedef unsigned short bf16_t;
typedef short bf16x8 __attribute__((ext_vector_type(8)));
typedef float f32x4 __attribute__((ext_vector_type(4)));
typedef unsigned u32x4 __attribute__((ext_vector_type(4)));
constexpr int BM = 256, BK = 64, HALF = 128, HTB = HALF * BK * 2  , STAGE_BYTES = 8 * HTB, NXCD = 8, WGM = 8;

__host__ __device__ __forceinline__ int lds_byte(int r, int c) { const int st = (r >> 4) * 2 + (c >> 5), rr = r & 15, cc = c & 31, ob = rr * 64 + cc * 2; return st * 1024 + (ob ^ (((ob >> 9) & 1) << 5)); }
__host__ __device__ __forceinline__ void stage_rc(int b, int& R, int& C) { const int st = b / 1024, sb = b % 1024, swz = sb ^ (((sb >> 9) & 1) << 5); R = (st >> 1) * 16 + swz / 64; C = (st & 1) * 32 + (swz % 64) / 2; }
__host__ __device__ __forceinline__ int perm32(int rho) { const int n = rho >> 4, i = rho & 15; return 8 * (i >> 2) + 4 * n + (i & 3); }

struct Unit { int pm, pn; };
struct Gemm { const bf16_t* A; const bf16_t* Bt; int M, N, K; };

struct StaticOrder {
    int nM, nN, nwg, G, c;
    __host__ __device__ void init(int M, int N, int G_, int c_) { nM = M / BM; nN = N / BM; nwg = nM * nN; G = G_; c = c_; }
    __host__ __device__ bool next(int i, Unit& u) const {
        const long L = (long)i * G + c; if (L >= nwg) return false;
        int wgid = (int)L; { const int q = nwg / NXCD, r = nwg % NXCD, xcd = wgid % NXCD, off = wgid / NXCD; wgid = (xcd < r ? xcd * (q + 1) : r * (q + 1) + (xcd - r) * q) + off; }
        const int nig = WGM * nN, gid = wgid / nig, fm = gid * WGM, gsz = (nM - fm) < WGM ? (nM - fm) : WGM;
        u.pm = fm + ((wgid % nig) % gsz); u.pn = (wgid % nig) / gsz; return true;
    }
    __device__ __forceinline__ void a_ready(const Unit&) const {}
    __device__ __forceinline__ void done(const Unit&) const {}
};
__device__ __forceinline__ unsigned cvt_pk_bf16(float lo, float hi) { unsigned r; asm volatile("v_cvt_pk_bf16_f32 %0, %1, %2" : "=v"(r) : "v"(lo), "v"(hi)); return r; }
template <class Epi, class Sched, bool ALIGN_EPI = false, bool SP2 = false>
__device__ __forceinline__ void gemm_phase(PG8_LAS unsigned char* lds, const Gemm g, const Sched& S, const Epi& E) {
    int tid_ = threadIdx.x; asm volatile("" : "+v"(tid_));
    const int tid = tid_, wid = __builtin_amdgcn_readfirstlane(tid >> 6), lane = tid & 63, wr = wid >> 2, wc = wid & 3, fr = lane & 15, fq = lane >> 4;
    const int K = g.K, nt = K / BK;
    unsigned voffA[2], voffB[2];
#pragma unroll
    for (int i = 0; i < 2; ++i) { int R, C; stage_rc(tid * 16 + i * 8192, R, C); const int Rb = Epi::PERM ? ((R & ~31) + perm32(R & 31)) : R;
        voffA[i] = (unsigned)(R * K + C) * 2u; voffB[i] = (unsigned)(Rb * K + C) * 2u; }
    const size_t kstep = (size_t)(BK * 2);
    const size_t hstep = (size_t)HALF * K * 2;
    const size_t tstep = 2 * hstep;
    const unsigned ldsw = (unsigned)wid * 1024u;
    const int aoff = lds_byte(wr * 64 + fr, fq * 8), boff = lds_byte(wc * 32 + fr, fq * 8);
#define PG8_SA(b, h) (((b) * 2 + (h)) * HTB)
#define PG8_SB(b, h) ((4 + (b) * 2 + (h)) * HTB)
#define PG8_STAGE(bufoff, gbase, voff) do { _Pragma("unroll") for (int _i = 0; _i < 2; ++_i) \
        __builtin_amdgcn_global_load_lds((const unsigned*)((const char*)(gbase) + (voff)[_i]), (PG8_LAS unsigned*)(lds + (bufoff) + ldsw + _i * 8192), 16, 0, 0); } while (0)
#define PG8_LDA(dst, b, h) do { _Pragma("unroll") for (int m = 0; m < 4; ++m) _Pragma("unroll") for (int k = 0; k < 2; ++k) dst[m][k] = *(const PG8_LAS bf16x8*)(lds + PG8_SA(b, h) + aoff + m * 2048 + k * 1024); } while (0)
#define PG8_LDB(dst, b, h) do { _Pragma("unroll") for (int n = 0; n < 2; ++n) _Pragma("unroll") for (int k = 0; k < 2; ++k) dst[n][k] = *(const PG8_LAS bf16x8*)(lds + PG8_SB(b, h) + boff + n * 2048 + k * 1024); } while (0)
#define PG8_MMA(ai, bj, At, Bt) do { __builtin_amdgcn_s_setprio(1); _Pragma("unroll") for (int m = 0; m < 4; ++m) _Pragma("unroll") for (int n = 0; n < 2; ++n) _Pragma("unroll") for (int k = 0; k < 2; ++k) \
        acc[ai][bj][m][n] = __builtin_amdgcn_mfma_f32_16x16x32_bf16(Bt[n][k], At[m][k], acc[ai][bj][m][n], 0, 0, 0); __builtin_amdgcn_s_setprio(0); } while (0)
#define PG8_WAIT_V(n) asm volatile("s_waitcnt vmcnt(" #n ")" ::: "memory")
#define PG8_WAIT_L(n) asm volatile("s_waitcnt lgkmcnt(" #n ")" ::: "memory")
#define PG8_BAR __builtin_amdgcn_s_barrier()
#define PG8_SCHED __builtin_amdgcn_sched_barrier(0)
    Unit cur, nxt; int ui = 0;
    if (!S.next(0, cur)) return;
    f32x4 acc[2][2][4][2];
#pragma unroll
    for (int a = 0; a < 2; ++a)
#pragma unroll
        for (int b = 0; b < 2; ++b)
#pragma unroll
            for (int m = 0; m < 4; ++m)
#pragma unroll
                for (int n = 0; n < 2; ++n) acc[a][b][m][n] = (f32x4){0.f, 0.f, 0.f, 0.f};
    bf16x8 At[4][2], B0[2][2], B1[2][2];
    const char* cA = (const char*)g.A + (size_t)cur.pm * tstep; const char* cB = (const char*)g.Bt + (size_t)cur.pn * tstep;
    S.a_ready(cur);
    if constexpr (SP2) {
        PG8_STAGE(PG8_SB(0, 0), cB, voffB); PG8_STAGE(PG8_SB(0, 1), cB + hstep, voffB); PG8_STAGE(PG8_SA(0, 0), cA, voffA); PG8_STAGE(PG8_SA(0, 1), cA + hstep, voffA);
        if (wr == 1) PG8_BAR;
        PG8_WAIT_V(2); PG8_BAR;
        PG8_STAGE(PG8_SB(1, 0), cB + kstep, voffB); PG8_STAGE(PG8_SA(1, 0), cA + kstep, voffA); PG8_STAGE(PG8_SB(1, 1), cB + hstep + kstep, voffB);
        PG8_WAIT_V(6); PG8_BAR;
    } else {
        PG8_STAGE(PG8_SB(0, 0), cB, voffB); PG8_STAGE(PG8_SA(0, 0), cA, voffA); PG8_STAGE(PG8_SB(0, 1), cB + hstep, voffB); PG8_STAGE(PG8_SA(0, 1), cA + hstep, voffA);
        if (wr == 1) PG8_BAR;
        PG8_WAIT_V(4); PG8_BAR;
        PG8_STAGE(PG8_SB(1, 0), cB + kstep, voffB); PG8_STAGE(PG8_SA(1, 0), cA + kstep, voffA); PG8_STAGE(PG8_SB(1, 1), cB + hstep + kstep, voffB);
        PG8_WAIT_V(6); PG8_BAR;
    }
    for (;;) {
        const bool has_next = S.next(ui + 1, nxt);
        const char* nA = has_next ? (const char*)g.A + (size_t)nxt.pm * tstep : cA; const char* nB = has_next ? (const char*)g.Bt + (size_t)nxt.pn * tstep : cB;
        for (int t = 0; t < nt; t += 2) {
            const bool last = (t == nt - 2);
            const char* a1 = cA + (size_t)(t + 1) * kstep;
            const char* a2 = last ? nA : cA + (size_t)(t + 2) * kstep; const char* b2 = last ? nB : cB + (size_t)(t + 2) * kstep;
            const char* a3 = a2 + kstep; const char* b3 = b2 + kstep;
            if (last && has_next) S.a_ready(nxt);
            if constexpr (SP2) {
            PG8_LDB(B0, 0, 0); PG8_LDB(B1, 0, 1); PG8_SCHED; PG8_LDA(At, 0, 0); PG8_STAGE(PG8_SA(1, 1), a1 + hstep, voffA);
            PG8_WAIT_V(8); PG8_WAIT_L(0); PG8_BAR; PG8_MMA(0, 0, At, B0); PG8_MMA(0, 1, At, B1); PG8_BAR; PG8_SCHED;
            PG8_LDA(At, 0, 1); PG8_STAGE(PG8_SB(0, 0), b2, voffB); PG8_STAGE(PG8_SB(0, 1), b2 + hstep, voffB); PG8_STAGE(PG8_SA(0, 0), a2, voffA);
            PG8_WAIT_V(8); PG8_WAIT_L(0); PG8_BAR; PG8_MMA(1, 0, At, B0); PG8_MMA(1, 1, At, B1); PG8_BAR; PG8_SCHED;
            PG8_LDB(B0, 1, 0); PG8_LDB(B1, 1, 1); PG8_SCHED; PG8_LDA(At, 1, 0); PG8_STAGE(PG8_SA(0, 1), a2 + hstep, voffA);
            PG8_WAIT_V(8); PG8_WAIT_L(0); PG8_BAR; PG8_MMA(0, 0, At, B0); PG8_MMA(0, 1, At, B1); PG8_BAR; PG8_SCHED;
            PG8_LDA(At, 1, 1); PG8_STAGE(PG8_SB(1, 0), b3, voffB); PG8_STAGE(PG8_SB(1, 1), b3 + hstep, voffB); PG8_STAGE(PG8_SA(1, 0), a3, voffA);
            PG8_WAIT_V(8); PG8_WAIT_L(0); PG8_BAR; PG8_MMA(1, 0, At, B0); PG8_MMA(1, 1, At, B1); PG8_BAR; PG8_SCHED;
            } else {
            PG8_LDB(B0, 0, 0); PG8_SCHED; PG8_LDA(At, 0, 0); PG8_STAGE(PG8_SA(1, 1), a1 + hstep, voffA);
            PG8_WAIT_L(8); PG8_BAR; PG8_WAIT_L(0); PG8_MMA(0, 0, At, B0); PG8_BAR; PG8_SCHED;
            PG8_LDB(B1, 0, 1); PG8_STAGE(PG8_SB(0, 0), b2, voffB);
            PG8_BAR; PG8_WAIT_L(0); PG8_MMA(0, 1, At, B1); PG8_BAR;
            PG8_LDA(At, 0, 1); PG8_STAGE(PG8_SA(0, 0), a2, voffA);
            PG8_BAR; PG8_WAIT_L(0); PG8_MMA(1, 0, At, B0); PG8_BAR; PG8_SCHED;
            PG8_STAGE(PG8_SB(0, 1), b2 + hstep, voffB);
            PG8_WAIT_V(6); PG8_BAR; PG8_MMA(1, 1, At, B1); PG8_BAR;
            PG8_LDB(B0, 1, 0); PG8_SCHED; PG8_LDA(At, 1, 0); PG8_STAGE(PG8_SA(0, 1), a2 + hstep, voffA);
            PG8_WAIT_L(8); PG8_BAR; PG8_WAIT_L(0); PG8_MMA(0, 0, At, B0); PG8_BAR; PG8_SCHED;
            PG8_LDB(B1, 1, 1); PG8_STAGE(PG8_SB(1, 0), b3, voffB);
            PG8_BAR; PG8_WAIT_L(0); PG8_MMA(0, 1, At, B1); PG8_BAR;
            PG8_LDA(At, 1, 1); PG8_STAGE(PG8_SA(1, 0), a3, voffA);
            PG8_BAR; PG8_WAIT_L(0); PG8_MMA(1, 0, At, B0); PG8_BAR; PG8_SCHED;
            PG8_STAGE(PG8_SB(1, 1), b3 + hstep, voffB);
            PG8_WAIT_V(6); PG8_BAR; PG8_MMA(1, 1, At, B1); PG8_BAR;
            }
        }
        if constexpr (ALIGN_EPI) { if (wr == 0) PG8_BAR; }
        if constexpr (!Epi::AFTER_DRAIN) { E(acc, cur, wr, wc, fr, fq); S.done(cur); }
        if (!has_next) break;
#pragma unroll
        for (int a = 0; a < 2; ++a)
#pragma unroll
            for (int b = 0; b < 2; ++b)
#pragma unroll
                for (int m = 0; m < 4; ++m)
#pragma unroll
                    for (int n = 0; n < 2; ++n) acc[a][b][m][n] = (f32x4){0.f, 0.f, 0.f, 0.f};
        cur = nxt; cA = nA; cB = nB; ++ui;
        if constexpr (ALIGN_EPI) { if (wr == 1) PG8_BAR; }
    }
    PG8_WAIT_V(0);
    if constexpr (!ALIGN_EPI) { if (wr == 0) PG8_BAR; }
    PG8_BAR;
    if constexpr (Epi::AFTER_DRAIN) { E.fused(acc, cur, wr, wc, fr, fq, lds, wid, lane); S.done(cur); }
#undef PG8_SA
#undef PG8_SB
#undef PG8_STAGE
#undef PG8_LDA
#undef PG8_LDB
#undef PG8_MMA
#undef PG8_WAIT_V
#undef PG8_WAIT_L
#undef PG8_BAR
#undef PG8_SCHED
}
}

constexpr int BATCH = 4, SEQ = 4096, DM = 1024, FF = 2816, NIN = 2304, M = BATCH * SEQ;
constexpr float RMS_EPS = 1e-6f, LOG2E = 1.4426950408889634f, C2 = 0.125f * LOG2E;
#define LAS __attribute__((address_space(3)))
typedef unsigned short bf16_t;
typedef short bf16x8 __attribute__((ext_vector_type(8)));
typedef short s16x4 __attribute__((ext_vector_type(4)));
typedef short v4i16_t __attribute__((ext_vector_type(4)));
typedef float f32x4 __attribute__((ext_vector_type(4)));
typedef float f32x16 __attribute__((ext_vector_type(16)));
typedef unsigned u32x4 __attribute__((ext_vector_type(4)));
typedef unsigned u32x2 __attribute__((ext_vector_type(2)));
typedef float f32x2_t __attribute__((ext_vector_type(2)));
typedef __bf16 bf16x2_t __attribute__((ext_vector_type(2)));

constexpr size_t OFF_GU1 = 0, OFF_D1 = OFF_GU1 + (size_t)2 * FF * DM, OFF_IN = OFF_D1 + (size_t)DM * FF, OFF_OUT = OFF_IN + (size_t)NIN * DM,
                 OFF_GU2 = OFF_OUT + (size_t)DM * DM, OFF_D2 = OFF_GU2 + (size_t)2 * FF * DM, LAYER_EL = OFF_D2 + (size_t)DM * FF;
constexpr size_t MiB = 1u << 20;
constexpr size_t WS_W = 0, WS_XB = 80 * MiB, WS_SS = 112 * MiB, WS_R = 114 * MiB, WS_HB = WS_R, WS_PROJ = WS_R, WS_MIX = WS_R + 72 * MiB, WS_CTL = 218 * MiB, CTL_BYTES = 65536, WS_END = 219 * MiB;
static_assert(2 * LAYER_EL * 2 <= WS_XB, "weights fit");
static_assert(WS_HB + (size_t)M * FF * 2 <= WS_END && WS_PROJ + (size_t)M * NIN * 2 <= WS_MIX && WS_MIX + (size_t)M * DM * 2 <= WS_CTL && WS_CTL + CTL_BYTES <= WS_END, "ws map");
constexpr int LDS_BYTES = 147456;
constexpr int NPHASE = 16;

struct Args { const float* in[19]; float* out; unsigned char* ws; int ph_lo, ph_hi; };

__device__ __forceinline__ int tid_opaque() { int t = threadIdx.x; asm volatile("" : "+v"(t)); return t; }
__device__ __forceinline__ unsigned cvtpk(float lo, float hi) { f32x2_t v = {lo, hi}; bf16x2_t b = __builtin_convertvector(v, bf16x2_t); return __builtin_bit_cast(unsigned, b); }
__device__ __forceinline__ float wave_sum(float v) {
#pragma unroll
    for (int o = 1; o < 64; o <<= 1) v += __shfl_xor(v, o);
    return v;
}
__device__ __forceinline__ float row_rstd(const float* __restrict__ ss, int row, int fq) {
    const f32x4 v = *(const f32x4*)(ss + (size_t)row * 16 + 4 * fq);
    float s = (v[0] + v[1]) + (v[2] + v[3]);
    s += __shfl_xor(s, 16); s += __shfl_xor(s, 32);
    return __builtin_amdgcn_rsqf(s * (1.0f / DM) + RMS_EPS);
}

struct EpiSwiGLU {
    static constexpr bool PERM = true, AFTER_DRAIN = false;
    bf16_t* H; const float* ss;
    __device__ __forceinline__ void operator()(const f32x4 (&acc)[2][2][4][2], const pg8::Unit& u, int wr, int wc, int fr, int fq) const {
        const int row0 = u.pm * 256 + wr * 64 + fr, col0 = u.pn * 128 + wc * 32 + 8 * fq;
#pragma unroll
        for (int ai = 0; ai < 2; ++ai)
#pragma unroll
            for (int m = 0; m < 4; ++m) {
                const int row = row0 + ai * 128 + m * 16;
                const float r = row_rstd(ss, row, fq);
                unsigned o[4];
#pragma unroll
                for (int n = 0; n < 2; ++n) {
                    float hv[4];
#pragma unroll
                    for (int i = 0; i < 4; ++i) {
                        const float g = acc[ai][0][m][n][i] * r, up = acc[ai][1][m][n][i] * r;
                        const float sg = g * __builtin_amdgcn_rcpf(1.0f + __builtin_amdgcn_exp2f(-g * LOG2E));
                        hv[i] = sg * up;
                    }
                    o[2 * n] = cvtpk(hv[0], hv[1]); o[2 * n + 1] = cvtpk(hv[2], hv[3]);
                }
                *(u32x4*)(H + (size_t)row * FF + col0) = (u32x4){o[0], o[1], o[2], o[3]};
            }
    }
};
struct EpiResid {
    static constexpr bool PERM = true, AFTER_DRAIN = false;
    const float* xin; float* xout; bf16_t* xb; float* ss; float scale; int last;
    __device__ __forceinline__ void operator()(const f32x4 (&acc)[2][2][4][2], const pg8::Unit& u, int wr, int wc, int fr, int fq) const {
        const int row0 = u.pm * 256 + wr * 64 + fr, col0 = u.pn * 256 + wc * 32 + 8 * fq;
#pragma unroll
        for (int ai = 0; ai < 2; ++ai)
#pragma unroll
            for (int m = 0; m < 4; ++m) {
                const int row = row0 + ai * 128 + m * 16;
                float sq = 0.f;
#pragma unroll
                for (int bj = 0; bj < 2; ++bj) {
                    const size_t idx = (size_t)row * DM + col0 + bj * 128;
                    const f32x4 a0 = *(const f32x4*)(xin + idx), a1 = *(const f32x4*)(xin + idx + 4);
                    const f32x4 v0 = a0 + acc[ai][bj][m][0] * scale, v1 = a1 + acc[ai][bj][m][1] * scale;
                    if (!last) { *(f32x4*)(xout + idx) = v0; *(f32x4*)(xout + idx + 4) = v1; }
                    *(u32x4*)(xb + idx) = (u32x4){cvtpk(v0[0], v0[1]), cvtpk(v0[2], v0[3]), cvtpk(v1[0], v1[1]), cvtpk(v1[2], v1[3])};
                    sq += (v0[0] * v0[0] + v0[1] * v0[1]) + (v0[2] * v0[2] + v0[3] * v0[3]) + (v1[0] * v1[0] + v1[1] * v1[1]) + (v1[2] * v1[2] + v1[3] * v1[3]);
                }
                sq += __shfl_xor(sq, 16); sq += __shfl_xor(sq, 32);
                if (fq == 0) ss[(size_t)row * 16 + u.pn * 4 + wc] = sq;
            }
    }
};
struct EpiProj {
    static constexpr bool PERM = true, AFTER_DRAIN = false;
    bf16_t* P; const float* ss;
    __device__ __forceinline__ void operator()(const f32x4 (&acc)[2][2][4][2], const pg8::Unit& u, int wr, int wc, int fr, int fq) const {
        const int row0 = u.pm * 256 + wr * 64 + fr, col0 = u.pn * 256 + wc * 32 + 8 * fq;
        const float cs = (u.pn < 2 || u.pn == 3 || u.pn == 4) ? C2 : 1.0f;
#pragma unroll
        for (int ai = 0; ai < 2; ++ai)
#pragma unroll
            for (int m = 0; m < 4; ++m) {
                const int row = row0 + ai * 128 + m * 16;
                const float r = row_rstd(ss, row, fq) * cs;
#pragma unroll
                for (int bj = 0; bj < 2; ++bj) {
                    const f32x4 v0 = acc[ai][bj][m][0] * r, v1 = acc[ai][bj][m][1] * r;
                    *(u32x4*)(P + (size_t)row * NIN + col0 + bj * 128) = (u32x4){cvtpk(v0[0], v0[1]), cvtpk(v0[2], v0[3]), cvtpk(v1[0], v1[1]), cvtpk(v1[2], v1[3])};
                }
            }
    }
};

__device__ __forceinline__ void transpose_item(const float* __restrict__ W, int K, int N, const float* __restrict__ gain, bf16_t* __restrict__ WT, int mode, LAS float* scr, int item, int lane) {
    const int nblk = N / 32, kb = item / nblk, nb = item % nblk, k0 = 64 * kb, n0 = 32 * nb;
    float wv[32];
    const float* wp = W + (size_t)(k0 + (lane >> 5)) * N + n0 + (lane & 31);
#pragma unroll
    for (int i = 0; i < 32; ++i) wv[i] = __builtin_nontemporal_load(wp + (size_t)(2 * i) * N);
#pragma unroll
    for (int i = 0; i < 32; ++i) { const int kk = 2 * i + (lane >> 5); scr[kk * 33 + (lane & 31)] = wv[i]; }
    asm volatile("s_waitcnt lgkmcnt(0)" ::: "memory");
    const int rb = mode == 0 ? n0 : ((n0 >> 7) * 256 + (n0 & 127) + (mode == 2 ? 128 : 0));
    const int c = lane & 7;
    f32x4 g0 = {1.f, 1.f, 1.f, 1.f}, g1 = g0;
    if (gain) { g0 = *(const f32x4*)(gain + k0 + 8 * c); g1 = *(const f32x4*)(gain + k0 + 8 * c + 4); }
#pragma unroll
    for (int j = 0; j < 4; ++j) { const int n = (lane >> 3) + 8 * j; const LAS float* s = scr + (8 * c) * 33 + n;
        u32x4 o; o.x = cvtpk(s[0 * 33] * g0[0], s[1 * 33] * g0[1]); o.y = cvtpk(s[2 * 33] * g0[2], s[3 * 33] * g0[3]); o.z = cvtpk(s[4 * 33] * g1[0], s[5 * 33] * g1[1]); o.w = cvtpk(s[6 * 33] * g1[2], s[7 * 33] * g1[3]);
        *(u32x4*)(WT + (size_t)(rb + n) * K + k0 + 8 * c) = o; }
    asm volatile("s_waitcnt lgkmcnt(0)" ::: "memory");
}
constexpr int I_GU = (DM / 64) * (FF / 32), I_D = (FF / 64) * (DM / 32), I_IN = (DM / 64) * (NIN / 32), I_OUT = (DM / 64) * (DM / 32);
constexpr int ITEMS_L = 4 * I_GU + 2 * I_D + I_IN + I_OUT;

__device__ __forceinline__ void convert_items(LAS unsigned char* lds, const Args& a, int it0, int it1, int gw, int NGW) {
    const int tid = tid_opaque(), lane = tid & 63, wave = __builtin_amdgcn_readfirstlane(tid >> 6);
    LAS float* scr = (LAS float*)(lds + wave * 16384);
    bf16_t* wbase = (bf16_t*)(a.ws + WS_W);
    for (int it = it0 + gw; it < it1; it += NGW) {
        const int l = it / ITEMS_L; int r = it % ITEMS_L;
        bf16_t* wl = wbase + (size_t)l * LAYER_EL;
        const float* W; const float* gain = nullptr; bf16_t* dst; int K = DM, N = FF, mode = 0;
        if (r < I_GU)                { W = a.in[2] + (size_t)l * DM * FF; gain = a.in[1] + l * DM; dst = wl + OFF_GU1; mode = 1; }
        else if ((r -= I_GU) < I_GU) { W = a.in[3] + (size_t)l * DM * FF; gain = a.in[1] + l * DM; dst = wl + OFF_GU1; mode = 2; }
        else if ((r -= I_GU) < I_D)  { W = a.in[4] + (size_t)l * FF * DM; dst = wl + OFF_D1; K = FF; N = DM; }
        else if ((r -= I_D) < I_IN)  { W = a.in[6] + (size_t)l * DM * NIN; gain = a.in[5] + l * DM; dst = wl + OFF_IN; N = NIN; }
        else if ((r -= I_IN) < I_OUT){ W = a.in[13] + (size_t)l * DM * DM; dst = wl + OFF_OUT; N = DM; }
        else if ((r -= I_OUT) < I_GU){ W = a.in[15] + (size_t)l * DM * FF; gain = a.in[14] + l * DM; dst = wl + OFF_GU2; mode = 1; }
        else if ((r -= I_GU) < I_GU) { W = a.in[16] + (size_t)l * DM * FF; gain = a.in[14] + l * DM; dst = wl + OFF_GU2; mode = 2; }
        else { r -= I_GU;              W = a.in[17] + (size_t)l * FF * DM; dst = wl + OFF_D2; K = FF; N = DM; }
        transpose_item(W, K, N, gain, dst, mode, scr, r, lane);
    }
}
__device__ __forceinline__ void filler_items(LAS unsigned char* lds, const Args& a, int it0, int it1, int nwg, int G, int c) {
    const int r = nwg % G;
    const int n_idle = r == 0 ? G : G - r, rank = r == 0 ? c : c - r;
    if (rank < 0) return;
    const int wave = __builtin_amdgcn_readfirstlane(tid_opaque() >> 6);
    convert_items(lds, a, it0, it1, rank * 8 + wave, n_idle * 8);
}
constexpr int IT_D1 = 2 * I_GU, IT_GU2 = IT_D1 + I_D + I_IN + I_OUT, IT_IN = IT_D1 + I_D, IT_D2 = IT_GU2 + 2 * I_GU;
__device__ __forceinline__ void prologue_phase(LAS unsigned char* lds, const Args& a, int vcu, int G) {
    const int tid = tid_opaque(), lane = tid & 63, wave = __builtin_amdgcn_readfirstlane(tid >> 6);
    const int gw = vcu * 8 + wave, NGW = G * 8;
    convert_items(lds, a, 0, IT_D1, gw, NGW);
    const float* x = a.in[0]; bf16_t* xb = (bf16_t*)(a.ws + WS_XB); float* ss = (float*)(a.ws + WS_SS);
    for (int row = gw; row < M; row += 4 * NGW) {
        f32x4 v[4][4];
#pragma unroll
        for (int q = 0; q < 4; ++q) { const int rr = row + q * NGW < M ? row + q * NGW : row; const f32x4* xr = (const f32x4*)(x + (size_t)rr * DM) + lane;
#pragma unroll
            for (int j = 0; j < 4; ++j) v[q][j] = __builtin_nontemporal_load(xr + 64 * j); }
#pragma unroll
        for (int q = 0; q < 4; ++q) { const int rr = row + q * NGW; if (rr < M) { u32x2* o = (u32x2*)(xb + (size_t)rr * DM) + lane; float s = 0.f;
#pragma unroll
            for (int j = 0; j < 4; ++j) { const f32x4 t = v[q][j]; s += (t[0] * t[0] + t[1] * t[1]) + (t[2] * t[2] + t[3] * t[3]); o[64 * j] = (u32x2){cvtpk(t[0], t[1]), cvtpk(t[2], t[3])}; }
            s = wave_sum(s);
            if (lane < 16) ss[(size_t)rr * 16 + lane] = lane == 0 ? s : 0.f; } }
    }
}
__device__ __forceinline__ void final_phase(const Args& a, int vcu, int G) {
    const int tid = tid_opaque(), lane = tid & 63, wave = __builtin_amdgcn_readfirstlane(tid >> 6);
    const int gw = vcu * 8 + wave, NGW = G * 8;
    const float* ss = (const float*)(a.ws + WS_SS); const float* gn = a.in[18];
    const f32x4* gr = (const f32x4*)gn + lane;
    f32x4 gv[4];
#pragma unroll
    for (int j = 0; j < 4; ++j) gv[j] = gr[64 * j];
    const bf16_t* xb = (const bf16_t*)(a.ws + WS_XB);
    for (int row = gw; row < M; row += 4 * NGW) {
        u32x2 v[4][4]; float r[4];
#pragma unroll
        for (int q = 0; q < 4; ++q) { const int rr = row + q * NGW < M ? row + q * NGW : row; const u32x2* xr = (const u32x2*)(xb + (size_t)rr * DM) + lane;
#pragma unroll
            for (int j = 0; j < 4; ++j) v[q][j] = xr[64 * j];
            const f32x4* sp = (const f32x4*)(ss + (size_t)rr * 16); float s = 0.f;
#pragma unroll
            for (int j = 0; j < 4; ++j) { const f32x4 t = sp[j]; s += (t[0] + t[1]) + (t[2] + t[3]); }
            r[q] = __builtin_amdgcn_rsqf(s * (1.0f / DM) + RMS_EPS); }
#pragma unroll
        for (int q = 0; q < 4; ++q) { const int rr = row + q * NGW; if (rr < M) { f32x4* xr = (f32x4*)(a.out + (size_t)rr * DM) + lane;
#pragma unroll
            for (int j = 0; j < 4; ++j) { const u32x2 t = v[q][j];
                const f32x4 xf = {__builtin_bit_cast(float, t[0] << 16), __builtin_bit_cast(float, t[0] & 0xffff0000u), __builtin_bit_cast(float, t[1] << 16), __builtin_bit_cast(float, t[1] & 0xffff0000u)};
                __builtin_nontemporal_store(xf * r[q] * gv[j], xr + 64 * j); } } }
    }
}

__device__ __forceinline__ int img_off(int row, int ch) { return 256 * row + 16 * (ch ^ (((row & 3) << 2) | ((row >> 2) & 3))); }
__device__ __forceinline__ s16x4 vtr(const LAS unsigned char* p) { return __builtin_bit_cast(s16x4, __builtin_amdgcn_ds_read_tr16_b64_v4i16((LAS v4i16_t*)p)); }

__device__ __forceinline__ void pack_p(const f32x16& s0, const f32x16& s1, float delta, bf16x8 (&pf)[4], float& rs) {
    float acc = 0.f;
#pragma unroll
    for (int sp = 0; sp < 4; ++sp) {
        float e[8];
#pragma unroll
        for (int j = 0; j < 8; ++j) { e[j] = __builtin_amdgcn_exp2f((sp < 2 ? s0[8 * sp + j] : s1[8 * (sp - 2) + j]) - delta); acc += e[j]; }
        const u32x4 t = {cvtpk(e[0], e[1]), cvtpk(e[2], e[3]), cvtpk(e[4], e[5]), cvtpk(e[6], e[7])};
        pf[sp] = __builtin_bit_cast(bf16x8, t);
    }
    rs = acc;
}
template <int MODE>
__device__ __forceinline__ void attn_unit(LAS unsigned char* lds, const bf16_t* __restrict__ proj, bf16_t* __restrict__ mix, int b, int qblk, int hj,
                                          const float* __restrict__ sink, const float* __restrict__ subln, float lam, float post) {
    constexpr int NEB = MODE ? 4 : 2;
    const int tid = tid_opaque(), lane = tid & 63, wid = __builtin_amdgcn_readfirstlane(tid >> 6);
    const int c = wid >> 2, w = wid & 3, hi = lane >> 5, l31 = lane & 31;
    int qcol, kcol, vcol, ocol, eb0; float slope2, m, l;
    if (MODE == 0) { const int hq = 4 * c + hj; qcol = hq * 64; kcol = 512; vcol = 640; ocol = hq * 64; eb0 = 2 * c;
        slope2 = __builtin_amdgcn_exp2f(-(float)(hq + 1)) * LOG2E; m = sink[hq] * LOG2E; l = hi ? 0.f : 1.f; }
    else { qcol = 768 + hj * 128 + c * 64; kcol = 1280 + hj * 128; vcol = 1792 + hj * 128; ocol = 512 + hj * 128; eb0 = 0;
        slope2 = __builtin_amdgcn_exp2f(-2.0f * (float)(hj + 1)) * LOG2E; m = 0.f; l = 0.f; }
    const size_t rowbase = (size_t)b * SEQ;
    const int qpos = qblk * 128 + w * 32 + l31;
    bf16x8 qf[4];
    { const bf16_t* qp = proj + (rowbase + qpos) * NIN + qcol + 8 * hi;
#pragma unroll
      for (int ks = 0; ks < 4; ++ks) qf[ks] = *(const bf16x8*)(qp + 16 * ks); }
    int kt0 = 0, kt1 = SEQ / 64;
    if (MODE == 0) { kt0 = qblk * 2 - 2 < 0 ? 0 : qblk * 2 - 2; kt1 = qblk * 2 + 4 > SEQ / 64 ? SEQ / 64 : qblk * 2 + 4; }
    const int nt = kt1 - kt0, ktbase = MODE ? 2 * qblk : kt0;
#define KT_OF(it) (MODE ? ((ktbase + (it)) & (SEQ / 64 - 1)) : (ktbase + (it)))
    const int qmin = qblk * 128 + w * 32;
    bool first = (MODE == 1);
    int kaddr[4];
#pragma unroll
    for (int ks = 0; ks < 4; ++ks) kaddr[ks] = img_off(l31, 8 * c + 2 * ks + hi);
    const int g = lane >> 4, q4 = (lane >> 2) & 3, p = lane & 3;
    int vaddr[NEB][2];
#pragma unroll
    for (int e = 0; e < NEB; ++e)
#pragma unroll
        for (int sec = 0; sec < 2; ++sec) vaddr[e][sec] = 65536 + img_off(4 * hi + q4 + 8 * sec, 4 * (eb0 + e) + 2 * (g & 1) + (p >> 1)) + 8 * (p & 1);
    const int prow = 4 * wid + (lane >> 4), pch = (lane & 15) ^ (((lane >> 4) << 2) | (wid & 3));
    const bf16_t* kg = proj + (rowbase + prow) * NIN + kcol + pch * 8;
    const bf16_t* vg = proj + (rowbase + prow) * NIN + vcol + pch * 8;
    const unsigned pdst = (unsigned)wid * 1024u;
#define STAGE_TILE(kt_, buf_, vbuf_) do { const size_t go_ = (size_t)(kt_) * 64 * NIN; LAS unsigned char* kb_ = lds + (buf_) * 16384 + pdst; LAS unsigned char* vb_ = lds + 65536 + (vbuf_) * 16384 + pdst; \
        __builtin_amdgcn_global_load_lds((const unsigned*)(kg + go_), (LAS unsigned*)kb_, 16, 0, 0); \
        __builtin_amdgcn_global_load_lds((const unsigned*)(kg + go_ + (size_t)32 * NIN), (LAS unsigned*)(kb_ + 8192), 16, 0, 0); \
        __builtin_amdgcn_global_load_lds((const unsigned*)(vg + go_), (LAS unsigned*)vb_, 16, 0, 0); \
        __builtin_amdgcn_global_load_lds((const unsigned*)(vg + go_ + (size_t)32 * NIN), (LAS unsigned*)(vb_ + 8192), 16, 0, 0); } while (0)
    f32x16 O[NEB];
#pragma unroll
    for (int e = 0; e < NEB; ++e)
#pragma unroll
        for (int r = 0; r < 16; ++r) O[e][r] = 0.f;

#define PACK_H(s_, delta_, rs_) do { float acc_ = 0.f; _Pragma("unroll") for (int sp = 0; sp < 2; ++sp) { float e_[8]; \
        _Pragma("unroll") for (int j = 0; j < 8; ++j) { e_[j] = __builtin_amdgcn_exp2f(s_[8 * sp + j] - (delta_)); acc_ += e_[j]; } \
        const u32x4 t_ = {cvtpk(e_[0], e_[1]), cvtpk(e_[2], e_[3]), cvtpk(e_[4], e_[5]), cvtpk(e_[6], e_[7])}; pfh[sp] = __builtin_bit_cast(bf16x8, t_); } rs_ = acc_; } while (0)
#define SOFTMAX_H(cur_, oth_) do { float rs_; PACK_H(cur_, 0.0f, rs_); \
        if (first || __builtin_amdgcn_ballot_w64(!(rs_ <= 16384.0f)) != 0ull) { \
            float mx_ = cur_[0]; \
            _Pragma("unroll") for (int r = 1; r < 16; ++r) mx_ = __builtin_fmaxf(mx_, cur_[r]); \
            mx_ = __builtin_fmaxf(mx_, __shfl_xor(mx_, 32)); \
            const float delta_ = first ? mx_ : __builtin_fmaxf(mx_, 0.0f); \
            const float alpha_ = __builtin_amdgcn_exp2f(-delta_); \
            m += delta_; l *= alpha_; \
            _Pragma("unroll") for (int e = 0; e < NEB; ++e) _Pragma("unroll") for (int r = 0; r < 16; ++r) O[e][r] *= alpha_; \
            _Pragma("unroll") for (int r = 0; r < 16; ++r) oth_[r] -= delta_; \
            PACK_H(cur_, delta_, rs_); \
            first = false; \
        } \
        l += rs_; } while (0)
#define HALF_STEP(cur_, oth_, ks_, kh_, vs_, vh_) do { \
        bf16x8 vf_[2 * NEB]; bf16x8 kf_[4]; \
        { const int vo_ = (vs_) * 16384 + 8192 * (vh_); \
          _Pragma("unroll") for (int sp = 0; sp < 2; ++sp) _Pragma("unroll") for (int e = 0; e < NEB; ++e) { \
            const s16x4 lo = vtr(lds + vaddr[e][0] + vo_ + 4096 * sp), hh = vtr(lds + vaddr[e][1] + vo_ + 4096 * sp); \
            vf_[sp * NEB + e] = (bf16x8){lo[0], lo[1], lo[2], lo[3], hh[0], hh[1], hh[2], hh[3]}; } \
          const int ko_ = (ks_) * 16384 + 8192 * (kh_); \
          _Pragma("unroll") for (int ks = 0; ks < 4; ++ks) kf_[ks] = *(const LAS bf16x8*)(lds + kaddr[ks] + ko_); } \
        __builtin_amdgcn_sched_barrier(0); \
        _Pragma("unroll") for (int ks = 0; ks < 4; ++ks) oth_ = __builtin_amdgcn_mfma_f32_32x32x16_bf16(kf_[ks], qf[ks], oth_, 0, 0, 0); \
        SOFTMAX_H(cur_, oth_); \
        _Pragma("unroll") for (int sp = 0; sp < 2; ++sp) _Pragma("unroll") for (int e = 0; e < NEB; ++e) O[e] = __builtin_amdgcn_mfma_f32_32x32x16_bf16(vf_[sp * NEB + e], pfh[sp], O[e], 0, 0, 0); \
    } while (0)
#define S_H(s_, slot_, h_) do { const LAS unsigned char* Kb_ = lds + (slot_) * 16384 + 8192 * (h_); bf16x8 kf_[4]; \
        _Pragma("unroll") for (int ks = 0; ks < 4; ++ks) kf_[ks] = *(const LAS bf16x8*)(Kb_ + kaddr[ks]); \
        _Pragma("unroll") for (int ks = 0; ks < 4; ++ks) s_ = __builtin_amdgcn_mfma_f32_32x32x16_bf16(kf_[ks], qf[ks], s_, 0, 0, 0); } while (0)
#define BIAS_H(s_, kt_, h_) do { const int k0_ = (kt_) * 64 + 32 * (h_); const float dq_ = (float)(qpos - k0_ - 4 * hi); \
        if (MODE == 1) { const float sg_ = k0_ < qmin ? slope2 : -slope2; const float base_ = __builtin_fmaf(-slope2, __builtin_fabsf(dq_), -m); \
            _Pragma("unroll") for (int r = 0; r < 16; ++r) { const float cc_ = (float)((r & 3) + 8 * (r >> 2)); s_[r] = __builtin_fmaf(sg_, cc_, base_); } } \
        if (MODE == 0 || k0_ == qmin) { \
            _Pragma("unroll") for (int r = 0; r < 16; ++r) { const float cc_ = (float)((r & 3) + 8 * (r >> 2)); \
                const float d0_ = __builtin_fabsf(dq_ - cc_); float a0_ = __builtin_fmaf(-slope2, d0_, -m); \
                if (MODE == 0) a0_ = d0_ > 128.0f ? -1e30f : a0_; \
                s_[r] = a0_; } } } while (0)
#define ATT_TRIP(it_, sl_) do { \
        if ((it_) + 2 < nt) asm volatile("s_waitcnt vmcnt(4)" ::: "memory"); else asm volatile("s_waitcnt vmcnt(0)" ::: "memory");     \
        __builtin_amdgcn_s_barrier();                                         \
        asm volatile("" ::: "memory"); \
        if ((it_) + 3 < nt) { STAGE_TILE(KT_OF((it_) + 3), ((sl_) + 3) & 3, ((sl_) + 3) & 3); } \
        HALF_STEP(sA, sB, (sl_), 1, (sl_), 0);                                \
        BIAS_H(sA, KT_OF((it_) + 1), 0); \
        HALF_STEP(sB, sA, ((sl_) + 1) & 3, 0, (sl_), 1);                      \
        BIAS_H(sB, KT_OF((it_) + 1), 1); \
    } while (0)
    bf16x8 pfh[2];
    f32x16 sA, sB;
    STAGE_TILE(KT_OF(0), 0, 0); STAGE_TILE(KT_OF(1), 1, 1); STAGE_TILE(KT_OF(2), 2, 2);
    BIAS_H(sA, KT_OF(0), 0);
    BIAS_H(sB, KT_OF(0), 1);
    asm volatile("s_waitcnt vmcnt(8)" ::: "memory");
    __builtin_amdgcn_s_barrier();
    asm volatile("" ::: "memory");
    S_H(sA, 0, 0);
    if (MODE == 1) { for (int it = 0; it < nt; it += 4) { ATT_TRIP(it, 0); ATT_TRIP(it + 1, 1); ATT_TRIP(it + 2, 2); ATT_TRIP(it + 3, 3); } }
    else { for (int it = 0; it < nt; ++it) ATT_TRIP(it, it & 3); }
    __syncthreads();
    const float lt = l + __shfl_xor(l, 32);
    const float inv = 1.0f / lt;
    bf16_t* op = mix + (rowbase + qpos) * DM + ocol + 4 * hi;
    if (MODE == 0) {
#pragma unroll
        for (int e = 0; e < NEB; ++e)
#pragma unroll
            for (int g4 = 0; g4 < 4; ++g4)
                *(u32x2*)(op + 32 * e + 8 * g4) = (u32x2){cvtpk(O[e][4 * g4] * inv, O[e][4 * g4 + 1] * inv), cvtpk(O[e][4 * g4 + 2] * inv, O[e][4 * g4 + 3] * inv)};
    } else {
        LAS float* X = (LAS float*)lds;
        if (c == 1) {
#pragma unroll
            for (int e = 0; e < NEB; ++e)
#pragma unroll
                for (int r = 0; r < 16; ++r) X[((w * 4 + e) * 16 + r) * 64 + lane] = O[e][r] * inv;
        }
        __syncthreads();
        if (c == 0) {
            float sq = 0.f;
#pragma unroll
            for (int e = 0; e < NEB; ++e)
#pragma unroll
                for (int r = 0; r < 16; ++r) { const float v = O[e][r] * inv - lam * X[((w * 4 + e) * 16 + r) * 64 + lane]; O[e][r] = v; sq += v * v; }
            sq += __shfl_xor(sq, 32);
            const float rn = __builtin_amdgcn_rsqf(sq * (1.0f / 128.0f) + RMS_EPS) * post;
#pragma unroll
            for (int e = 0; e < NEB; ++e)
#pragma unroll
                for (int g4 = 0; g4 < 4; ++g4) {
                    const f32x4 gv = *(const f32x4*)(subln + 32 * e + 8 * g4 + 4 * hi);
                    *(u32x2*)(op + 32 * e + 8 * g4) = (u32x2){cvtpk(O[e][4 * g4] * rn * gv[0], O[e][4 * g4 + 1] * rn * gv[1]), cvtpk(O[e][4 * g4 + 2] * rn * gv[2], O[e][4 * g4 + 3] * rn * gv[3])};
                }
        }
    }
    __syncthreads();
}

__device__ __forceinline__ void attn_phase(LAS unsigned char* lds, const Args& a, int layer, int vcu, int G) {
    const bf16_t* proj = (const bf16_t*)(a.ws + WS_PROJ); bf16_t* mix = (bf16_t*)(a.ws + WS_MIX);
    const int lane = tid_opaque() & 63;
    const float a1 = wave_sum(a.in[8][layer * 64 + lane] * a.in[9][layer * 64 + lane]);
    const float a2 = wave_sum(a.in[10][layer * 64 + lane] * a.in[11][layer * 64 + lane]);
    const float lam_init = layer ? 0.35550906759096927f : 0.2f;
    const float lam = __expf(a1) - __expf(a2) + lam_init;
    const float post = 1.0f - lam_init;
    for (int u = vcu; u < BATCH * 4 * (SEQ / 128); u += G) { const int bh = u >> 5, qblk = u & 31;
        attn_unit<1>(lds, proj, mix, bh >> 2, qblk, bh & 3, nullptr, a.in[12] + layer * 128, lam, post); }
    for (int u = vcu; u < BATCH * 4 * (SEQ / 128); u += G) { const int b = u >> 7, rem = u & 127, qblk = rem >> 2, hj = rem & 3;
        attn_unit<0>(lds, proj, mix, b, qblk, hj, a.in[7] + layer * 8, nullptr, 0.f, 0.f); }
}

#define XB_TMO      128
#define XB_XCNT(j)  (256  + 64 * (j))
#define XB_XSUB(j)  (1280 + 64 * (j))
#define XB_XGEN(j)  (2304 + 64 * (j))
#define XB_TOP      3328
#define XB_TOPGEN   3392
#define XCD_BAR_WORDS 3456
#define XB_SPIN_CAP (1u << 18)

__device__ __forceinline__ unsigned xb_ld(unsigned* p)              { return __hip_atomic_load(p, __ATOMIC_RELAXED, __HIP_MEMORY_SCOPE_AGENT); }
__device__ __forceinline__ unsigned xb_add(unsigned* p, unsigned v) { return __hip_atomic_fetch_add(p, v, __ATOMIC_RELAXED, __HIP_MEMORY_SCOPE_AGENT); }
__device__ __forceinline__ unsigned xb_xcc_id() { return (unsigned)__builtin_amdgcn_s_getreg((3 << 11) | 20) & 0xFu; }
#define XB_SPIN(cond, bar) do { unsigned _sp = 0; while (cond) { __builtin_amdgcn_s_sleep(1); \
    if ((++_sp & 255u) == 0u) { if (xb_ld(&(bar)[XB_TMO])) break; if (_sp > XB_SPIN_CAP) { atomicAdd(&(bar)[XB_TMO], 1u); break; } } } } while (0)

struct XcdBarrier {
    unsigned* bar; unsigned x;
    volatile LAS unsigned* st;
};

__device__ __forceinline__ XcdBarrier xcd_barrier_post(unsigned* bar, volatile LAS unsigned* st) {
    XcdBarrier b; b.bar = bar; b.x = xb_xcc_id(); b.st = st;
    if (threadIdx.x == 0) (void)xb_add(&bar[XB_XCNT(b.x)], 1u);
    return b;
}
__device__ __forceinline__ void xcd_barrier_complete(unsigned* bar, unsigned x, unsigned& nloc, unsigned& nx) {
    const unsigned G = gridDim.x * gridDim.y * gridDim.z;
    unsigned sum, cnt, mine, sp = 0u;
    for (;;) {
        sum = 0u; cnt = 0u; mine = 0u;
#pragma unroll
        for (unsigned j = 0; j < 16; ++j) { const unsigned c = xb_ld(&bar[XB_XCNT(j)]); sum += c; cnt += (c > 0u) ? 1u : 0u; mine = (j == x) ? c : mine; }
        if (sum == G) break;
        __builtin_amdgcn_s_sleep(1);
        if ((++sp & 255u) == 0u) { if (xb_ld(&bar[XB_TMO])) break; if (sp > XB_SPIN_CAP) { atomicAdd(&bar[XB_TMO], 1u); break; } }
    }
    nloc = mine > 0u ? mine : 1u; nx = cnt > 0u ? cnt : 1u;
}

__device__ __forceinline__ void xcd_barrier(const XcdBarrier& b) {
    asm volatile("s_waitcnt vmcnt(0)" ::: "memory");
    __syncthreads();
    if (threadIdx.x == 0) {
        unsigned* bar = b.bar;
        __builtin_amdgcn_s_waitcnt(0);
        unsigned nloc = b.st[0], nx = b.st[1];
        if (nloc == 0u) { xcd_barrier_complete(bar, b.x, nloc, nx); b.st[0] = nloc; b.st[1] = nx; }
        const unsigned old = xb_add(&bar[XB_XSUB(b.x)], 1u);
        const unsigned gen = old / nloc;
        if (old + 1u == (gen + 1u) * nloc) {
            __builtin_amdgcn_fence(__ATOMIC_RELEASE, "agent");
            asm volatile("s_waitcnt vmcnt(0)" ::: "memory");
            const unsigned og = xb_add(&bar[XB_TOP], 1u);
            const unsigned tg = og / nx;
            if (og + 1u == (tg + 1u) * nx) xb_add(&bar[XB_TOPGEN], 1u);
            else XB_SPIN(xb_ld(&bar[XB_TOPGEN]) == tg, bar);
            __builtin_amdgcn_fence(__ATOMIC_ACQUIRE, "agent");
            xb_add(&bar[XB_XGEN(b.x)], 1u);
            asm volatile("s_waitcnt vmcnt(0)" ::: "memory");
        } else {
            XB_SPIN(xb_ld(&bar[XB_XGEN(b.x)]) == gen, bar);
            __builtin_amdgcn_fence(__ATOMIC_ACQUIRE, "agent");
            asm volatile("s_waitcnt vmcnt(0)" ::: "memory");
        }
    }
    __syncthreads();
}

__global__ void __launch_bounds__(512, 2) fwd_kernel(Args a0) {
    extern __shared__ __attribute__((aligned(16))) unsigned char lds_raw[];
    LAS unsigned char* lds = (LAS unsigned char*)lds_raw;
    const int G = gridDim.x, bx = blockIdx.x;
    const int vcu = (G % 8 == 0) ? (bx % 8) * (G / 8) + bx / 8 : bx;
    const int ph_lo = a0.ph_lo, ph_hi = a0.ph_hi;
    volatile LAS unsigned* st = (volatile LAS unsigned*)(lds + LDS_BYTES - 64);
    if (threadIdx.x < 16) st[threadIdx.x] = 0u;
    __syncthreads();
    XcdBarrier bar = xcd_barrier_post((unsigned*)(a0.ws + WS_CTL), st);
    for (int ph = ph_lo; ph < ph_hi; ++ph) {
        auto ap4 = __builtin_amdgcn_kernarg_segment_ptr();
        asm volatile("" : "+s"(ap4));
        const Args& a = *(const Args*)ap4;
        bf16_t* xb = (bf16_t*)(a.ws + WS_XB); float* ss = (float*)(a.ws + WS_SS); bf16_t* hb = (bf16_t*)(a.ws + WS_HB);
        bf16_t* proj = (bf16_t*)(a.ws + WS_PROJ); bf16_t* mix = (bf16_t*)(a.ws + WS_MIX);
        if (ph == 0) prologue_phase(lds, a, vcu, G);
        else if (ph == NPHASE - 1) final_phase(a, vcu, G);
        else {
            const int layer = (ph - 1) / 7, k = (ph - 1) % 7;
            const bf16_t* wl = (const bf16_t*)(a.ws + WS_W) + (size_t)layer * LAYER_EL;
            if (k == 0 || k == 5) {
                pg8::Gemm g{xb, wl + (k == 0 ? OFF_GU1 : OFF_GU2), M, 2 * FF, DM}; pg8::StaticOrder S; S.init(M, 2 * FF, G, bx);
                EpiSwiGLU E{hb, ss};
                pg8::gemm_phase<EpiSwiGLU, pg8::StaticOrder, true, true>(lds, g, S, E);
                {
                    const int f0 = layer == 0 ? (k == 0 ? IT_D1 : ITEMS_L) : (k == 0 ? ITEMS_L + IT_IN + I_IN : 0);
                    const int f1 = layer == 0 ? (k == 0 ? IT_GU2 : ITEMS_L + IT_IN + I_IN) : (k == 0 ? ITEMS_L + IT_D2 : 0);
                    if (f1 > f0) filler_items(lds, a, f0, f1, (M / 256) * (2 * FF / 256), G, bx);
                }
            } else if (k == 1 || k == 6 || k == 4) {
                const bool wo = (k == 4);
                pg8::Gemm g{wo ? mix : hb, wl + (k == 1 ? OFF_D1 : (k == 6 ? OFF_D2 : OFF_OUT)), M, DM, wo ? DM : FF}; pg8::StaticOrder S; S.init(M, DM, G, bx);
                EpiResid E{(layer == 0 && k == 1) ? a.in[0] : a.out, a.out, xb, ss, wo ? 1.0f : 0.5f, (layer == 1 && k == 6) ? 1 : 0};
                pg8::gemm_phase<EpiResid, pg8::StaticOrder, true, true>(lds, g, S, E);
            } else if (k == 2) {
                pg8::Gemm g{xb, wl + OFF_IN, M, NIN, DM}; pg8::StaticOrder S; S.init(M, NIN, G, bx);
                EpiProj E{proj, ss};
                pg8::gemm_phase<EpiProj, pg8::StaticOrder, true, true>(lds, g, S, E);
                filler_items(lds, a, layer == 0 ? IT_GU2 : ITEMS_L + IT_D2, layer == 0 ? ITEMS_L : 2 * ITEMS_L, (M / 256) * (NIN / 256), G, bx);
            } else {
                attn_phase(lds, a, layer, vcu, G);
            }
        }
        if (ph + 1 < ph_hi) {
            if (ph_lo < 0) cg::this_grid().sync();
            xcd_barrier(bar);
        }
    }
}

#ifndef MK_PER_PHASE
#define MK_PER_PHASE 0
#endif
extern "C" void kernel_launch(void* const* d_in, const int* in_sizes, int n_in, void* d_out, int out_size, void* d_ws, size_t ws_size, hipStream_t stream) {
    static int grid = 0;
    if (grid == 0) {
        if (n_in != 19 || in_sizes[0] != M * DM || out_size != M * DM || ws_size < WS_END) { fprintf(stderr, "kernel_launch: unexpected shapes (n_in %d, in0 %d, out %d, ws %zu)\n", n_in, n_in > 0 ? in_sizes[0] : -1, out_size, ws_size); grid = -1; return; }
        int dev = 0, cus = 0, per_cu = 0;
        if (hipGetDevice(&dev) != hipSuccess || hipDeviceGetAttribute(&cus, hipDeviceAttributeMultiprocessorCount, dev) != hipSuccess) { grid = -1; return; }
        if (hipFuncSetAttribute((const void*)fwd_kernel, hipFuncAttributeMaxDynamicSharedMemorySize, LDS_BYTES) != hipSuccess) { fprintf(stderr, "kernel_launch: hipFuncSetAttribute failed\n"); grid = -1; return; }
        if (hipOccupancyMaxActiveBlocksPerMultiprocessor(&per_cu, (const void*)fwd_kernel, 512, LDS_BYTES) != hipSuccess || per_cu < 1) { fprintf(stderr, "kernel_launch: occupancy query gave %d\n", per_cu); per_cu = 1; }
        (void)hipGetLastError();
        grid = cus;
    }
    if (grid < 0) return;
    Args a{};
    for (int i = 0; i < 19; ++i) a.in[i] = (const float*)d_in[i];
    a.out = (float*)d_out; a.ws = (unsigned char*)d_ws;
    if (hipMemsetAsync((char*)d_ws + WS_CTL, 0, CTL_BYTES, stream) != hipSuccess) { fprintf(stderr, "kernel_launch: memset of the barrier words failed\n"); return; }
#if MK_PER_PHASE
    for (int ph = 0; ph < NPHASE; ++ph) { a.ph_lo = ph; a.ph_hi = ph + 1; hipLaunchKernelGGL(fwd_kernel, dim3(grid), dim3(512), LDS_BYTES, stream, a); }
#else
    a.ph_lo = 0; a.ph_hi = NPHASE;
    void* kargs[] = {&a};
    const hipError_t e = hipLaunchCooperativeKernel((const void*)fwd_kernel, dim3(grid), dim3(512), kargs, LDS_BYTES, stream);
    if (e != hipSuccess) fprintf(stderr, "kernel_launch: cooperative launch failed: %s (grid %d)\n", hipGetErrorString(e), grid);
#endif
}
```

```cpp
#include <hip/hip_runtime.h>
#include <hip/hip_cooperative_groups.h>
#include <cstdio>
#include <cstdint>
namespace cg = cooperative_groups;
namespace pg8 {
#define PG8_LAS __attribute__((address_space(3)))
typedef unsigned short bf16_t;
typedef short bf16x8 __attribute__((ext_vector_type(8)));
typedef float f32x4 __attribute__((ext_vector_type(4)));
typedef unsigned u32x4 __attribute__((ext_vector_type(4)));
constexpr int BM = 256, BK = 64, HALF = 128, HTB = HALF * BK * 2  , STAGE_BYTES = 8 * HTB, NXCD = 8, WGM = 8;

__host__ __device__ __forceinline__ int lds_byte(int r, int c) { const int st = (r >> 4) * 2 + (c >> 5), rr = r & 15, cc = c & 31, ob = rr * 64 + cc * 2; return st * 1024 + (ob ^ (((ob >> 9) & 1) << 5)); }
__host__ __device__ __forceinline__ void stage_rc(int b, int& R, int& C) { const int st = b / 1024, sb = b % 1024, swz = sb ^ (((sb >> 9) & 1) << 5); R = (st >> 1) * 16 + swz / 64; C = (st & 1) * 32 + (swz % 64) / 2; }
__host__ __device__ __forceinline__ int perm32(int rho) { const int n = rho >> 4, i = rho & 15; return 8 * (i >> 2) + 4 * n + (i & 3); }

struct Unit { int pm, pn; };
struct Gemm { const bf16_t* A; const bf16_t* Bt; int M, N, K; };

struct StaticOrder {
    int nM, nN, nwg, G, c;
    __host__ __device__ void init(int M, int N, int G_, int c_) { nM = M / BM; nN = N / BM; nwg = nM * nN; G = G_; c = c_; }
    __host__ __device__ bool next(int i, Unit& u) const {
        const long L = (long)i * G + c; if (L >= nwg) return false;
        int wgid = (int)L; { const int q = nwg / NXCD, r = nwg % NXCD, xcd = wgid % NXCD, off = wgid / NXCD; wgid = (xcd < r ? xcd * (q + 1) : r * (q + 1) + (xcd - r) * q) + off; }
        const int nig = WGM * nN, gid = wgid / nig, fm = gid * WGM, gsz = (nM - fm) < WGM ? (nM - fm) : WGM;
        u.pm = fm + ((wgid % nig) % gsz); u.pn = (wgid % nig) / gsz; return true;
    }
    __device__ __forceinline__ void a_ready(const Unit&) const {}
    __device__ __forceinline__ void done(const Unit&) const {}
};
__device__ __forceinline__ unsigned cvt_pk_bf16(float lo, float hi) { unsigned r; asm volatile("v_cvt_pk_bf16_f32 %0, %1, %2" : "=v"(r) : "v"(lo), "v"(hi)); return r; }
template <class Epi, class Sched, bool ALIGN_EPI = false, bool SP2 = false>
__device__ __forceinline__ void gemm_phase(PG8_LAS unsigned char* lds, const Gemm g, const Sched& S, const Epi& E) {
    int tid_ = threadIdx.x; asm volatile("" : "+v"(tid_));
    const int tid = tid_, wid = __builtin_amdgcn_readfirstlane(tid >> 6), lane = tid & 63, wr = wid >> 2, wc = wid & 3, fr = lane & 15, fq = lane >> 4;
    const int K = g.K, nt = K / BK;
    unsigned voffA[2], voffB[2];
#pragma unroll
    for (int i = 0; i < 2; ++i) { int R, C; stage_rc(tid * 16 + i * 8192, R, C); const int Rb = Epi::PERM ? ((R & ~31) + perm32(R & 31)) : R;
        voffA[i] = (unsigned)(R * K + C) * 2u; voffB[i] = (unsigned)(Rb * K + C) * 2u; }
    const size_t kstep = (size_t)(BK * 2);
    const size_t hstep = (size_t)HALF * K * 2;
    const size_t tstep = 2 * hstep;
    const unsigned ldsw = (unsigned)wid * 1024u;
    const int aoff = lds_byte(wr * 64 + fr, fq * 8), boff = lds_byte(wc * 32 + fr, fq * 8);
#define PG8_SA(b, h) (((b) * 2 + (h)) * HTB)
#define PG8_SB(b, h) ((4 + (b) * 2 + (h)) * HTB)
#define PG8_STAGE(bufoff, gbase, voff) do { _Pragma("unroll") for (int _i = 0; _i < 2; ++_i) \
        __builtin_amdgcn_global_load_lds((const unsigned*)((const char*)(gbase) + (voff)[_i]), (PG8_LAS unsigned*)(lds + (bufoff) + ldsw + _i * 8192), 16, 0, 0); } while (0)
#define PG8_LDA(dst, b, h) do { _Pragma("unroll") for (int m = 0; m < 4; ++m) _Pragma("unroll") for (int k = 0; k < 2; ++k) dst[m][k] = *(const PG8_LAS bf16x8*)(lds + PG8_SA(b, h) + aoff + m * 2048 + k * 1024); } while (0)
#define PG8_LDB(dst, b, h) do { _Pragma("unroll") for (int n = 0; n < 2; ++n) _Pragma("unroll") for (int k = 0; k < 2; ++k) dst[n][k] = *(const PG8_LAS bf16x8*)(lds + PG8_SB(b, h) + boff + n * 2048 + k * 1024); } while (0)
#define PG8_MMA(ai, bj, At, Bt) do { __builtin_amdgcn_s_setprio(1); _Pragma("unroll") for (int m = 0; m < 4; ++m) _Pragma("unroll") for (int n = 0; n < 2; ++n) _Pragma("unroll") for (int k = 0; k < 2; ++k) \
        acc[ai][bj][m][n] = __builtin_amdgcn_mfma_f32_16x16x32_bf16(Bt[n][k], At[m][k], acc[ai][bj][m][n], 0, 0, 0); __builtin_amdgcn_s_setprio(0); } while (0)
#define PG8_WAIT_V(n) asm volatile("s_waitcnt vmcnt(" #n ")" ::: "memory")
#define PG8_WAIT_L(n) asm volatile("s_waitcnt lgkmcnt(" #n ")" ::: "memory")
#define PG8_BAR __builtin_amdgcn_s_barrier()
#define PG8_SCHED __builtin_amdgcn_sched_barrier(0)
    Unit cur, nxt; int ui = 0;
    if (!S.next(0, cur)) return;
    f32x4 acc[2][2][4][2];
#pragma unroll
    for (int a = 0; a < 2; ++a)
#pragma unroll
        for (int b = 0; b < 2; ++b)
#pragma unroll
            for (int m = 0; m < 4; ++m)
#pragma unroll
                for (int n = 0; n < 2; ++n) acc[a][b][m][n] = (f32x4){0.f, 0.f, 0.f, 0.f};
    bf16x8 At[4][2], B0[2][2], B1[2][2];
    const char* cA = (const char*)g.A + (size_t)cur.pm * tstep; const char* cB = (const char*)g.Bt + (size_t)cur.pn * tstep;
    S.a_ready(cur);
    if constexpr (SP2) {
        PG8_STAGE(PG8_SB(0, 0), cB, voffB); PG8_STAGE(PG8_SB(0, 1), cB + hstep, voffB); PG8_STAGE(PG8_SA(0, 0), cA, voffA); PG8_STAGE(PG8_SA(0, 1), cA + hstep, voffA);
        if (wr == 1) PG8_BAR;
        PG8_WAIT_V(2); PG8_BAR;
        PG8_STAGE(PG8_SB(1, 0), cB + kstep, voffB); PG8_STAGE(PG8_SA(1, 0), cA + kstep, voffA); PG8_STAGE(PG8_SB(1, 1), cB + hstep + kstep, voffB);
        PG8_WAIT_V(6); PG8_BAR;
    } else {
        PG8_STAGE(PG8_SB(0, 0), cB, voffB); PG8_STAGE(PG8_SA(0, 0), cA, voffA); PG8_STAGE(PG8_SB(0, 1), cB + hstep, voffB); PG8_STAGE(PG8_SA(0, 1), cA + hstep, voffA);
        if (wr == 1) PG8_BAR;
        PG8_WAIT_V(4); PG8_BAR;
        PG8_STAGE(PG8_SB(1, 0), cB + kstep, voffB); PG8_STAGE(PG8_SA(1, 0), cA + kstep, voffA); PG8_STAGE(PG8_SB(1, 1), cB + hstep + kstep, voffB);
        PG8_WAIT_V(6); PG8_BAR;
    }
    for (;;) {
        const bool has_next = S.next(ui + 1, nxt);
        const char* nA = has_next ? (const char*)g.A + (size_t)nxt.pm * tstep : cA; const char* nB = has_next ? (const char*)g.Bt + (size_t)nxt.pn * tstep : cB;
        for (int t = 0; t < nt; t += 2) {
            const bool last = (t == nt - 2);
            const char* a1 = cA + (size_t)(t + 1) * kstep;
            const char* a2 = last ? nA : cA + (size_t)(t + 2) * kstep; const char* b2 = last ? nB : cB + (size_t)(t + 2) * kstep;
            const char* a3 = a2 + kstep; const char* b3 = b2 + kstep;
            if (last && has_next) S.a_ready(nxt);
            if constexpr (SP2) {
            PG8_LDB(B0, 0, 0); PG8_LDB(B1, 0, 1); PG8_SCHED; PG8_LDA(At, 0, 0); PG8_STAGE(PG8_SA(1, 1), a1 + hstep, voffA);
            PG8_WAIT_V(8); PG8_WAIT_L(0); PG8_BAR; PG8_MMA(0, 0, At, B0); PG8_MMA(0, 1, At, B1); PG8_BAR; PG8_SCHED;
            PG8_LDA(At, 0, 1); PG8_STAGE(PG8_SB(0, 0), b2, voffB); PG8_STAGE(PG8_SB(0, 1), b2 + hstep, voffB); PG8_STAGE(PG8_SA(0, 0), a2, voffA);
            PG8_WAIT_V(8); PG8_WAIT_L(0); PG8_BAR; PG8_MMA(1, 0, At, B0); PG8_MMA(1, 1, At, B1); PG8_BAR; PG8_SCHED;
            PG8_LDB(B0, 1, 0); PG8_LDB(B1, 1, 1); PG8_SCHED; PG8_LDA(At, 1, 0); PG8_STAGE(PG8_SA(0, 1), a2 + hstep, voffA);
            PG8_WAIT_V(8); PG8_WAIT_L(0); PG8_BAR; PG8_MMA(0, 0, At, B0); PG8_MMA(0, 1, At, B1); PG8_BAR; PG8_SCHED;
            PG8_LDA(At, 1, 1); PG8_STAGE(PG8_SB(1, 0), b3, voffB); PG8_STAGE(PG8_SB(1, 1), b3 + hstep, voffB); PG8_STAGE(PG8_SA(1, 0), a3, voffA);
            PG8_WAIT_V(8); PG8_WAIT_L(0); PG8_BAR; PG8_MMA(1, 0, At, B0); PG8_MMA(1, 1, At, B1); PG8_BAR; PG8_SCHED;
            } else {
            PG8_LDB(B0, 0, 0); PG8_SCHED; PG8_LDA(At, 0, 0); PG8_STAGE(PG8_SA(1, 1), a1 + hstep, voffA);
            PG8_WAIT_L(8); PG8_BAR; PG8_WAIT_L(0); PG8_MMA(0, 0, At, B0); PG8_BAR; PG8_SCHED;
            PG8_LDB(B1, 0, 1); PG8_STAGE(PG8_SB(0, 0), b2, voffB);
            PG8_BAR; PG8_WAIT_L(0); PG8_MMA(0, 1, At, B1); PG8_BAR;
            PG8_LDA(At, 0, 1); PG8_STAGE(PG8_SA(0, 0), a2, voffA);
            PG8_BAR; PG8_WAIT_L(0); PG8_MMA(1, 0, At, B0); PG8_BAR; PG8_SCHED;
            PG8_STAGE(PG8_SB(0, 1), b2 + hstep, voffB);
            PG8_WAIT_V(6); PG8_BAR; PG8_MMA(1, 1, At, B1); PG8_BAR;
            PG8_LDB(B0, 1, 0); PG8_SCHED; PG8_LDA(At, 1, 0); PG8_STAGE(PG8_SA(0, 1), a2 + hstep, voffA);
            PG8_WAIT_L(8); PG8_BAR; PG8_WAIT_L(0); PG8_MMA(0, 0, At, B0); PG8_BAR; PG8_SCHED;
            PG8_LDB(B1, 1, 1); PG8_STAGE(PG8_SB(1, 0), b3, voffB);
            PG8_BAR; PG8_WAIT_L(0); PG8_MMA(0, 1, At, B1); PG8_BAR;
            PG8_LDA(At, 1, 1); PG8_STAGE(PG8_SA(1, 0), a3, voffA);
            PG8_BAR; PG8_WAIT_L(0); PG8_MMA(1, 0, At, B0); PG8_BAR; PG8_SCHED;
            PG8_STAGE(PG8_SB(1, 1), b3 + hstep, voffB);
            PG8_WAIT_V(6); PG8_BAR; PG8_MMA(1, 1, At, B1); PG8_BAR;
            }
        }
        if constexpr (ALIGN_EPI) { if (wr == 0) PG8_BAR; }
        if constexpr (!Epi::AFTER_DRAIN) { E(acc, cur, wr, wc, fr, fq); S.done(cur); }
        if (!has_next) break;
#pragma unroll
        for (int a = 0; a < 2; ++a)
#pragma unroll
            for (int b = 0; b < 2; ++b)
#pragma unroll
                for (int m = 0; m < 4; ++m)
#pragma unroll
                    for (int n = 0; n < 2; ++n) acc[a][b][m][n] = (f32x4){0.f, 0.f, 0.f, 0.f};
        cur = nxt; cA = nA; cB = nB; ++ui;
        if constexpr (ALIGN_EPI) { if (wr == 1) PG8_BAR; }
    }
    PG8_WAIT_V(0);
    if constexpr (!ALIGN_EPI) { if (wr == 0) PG8_BAR; }
    PG8_BAR;
    if constexpr (Epi::AFTER_DRAIN) { E.fused(acc, cur, wr, wc, fr, fq, lds, wid, lane); S.done(cur); }
#undef PG8_SA
#undef PG8_SB
#undef PG8_STAGE
#undef PG8_LDA
#undef PG8_LDB
#undef PG8_MMA
#undef PG8_WAIT_V
#undef PG8_WAIT_L
#undef PG8_BAR
#undef PG8_SCHED
}
}

constexpr int BATCH = 4, SEQ = 4096, DM = 1024, FF = 2816, NIN = 2304, M = BATCH * SEQ;
constexpr float RMS_EPS = 1e-6f, LOG2E = 1.4426950408889634f, C2 = 0.125f * LOG2E;
#define LAS __attribute__((address_space(3)))
typedef unsigned short bf16_t;
typedef short bf16x8 __attribute__((ext_vector_type(8)));
typedef short s16x4 __attribute__((ext_vector_type(4)));
typedef short v4i16_t __attribute__((ext_vector_type(4)));
typedef float f32x4 __attribute__((ext_vector_type(4)));
typedef float f32x16 __attribute__((ext_vector_type(16)));
typedef unsigned u32x4 __attribute__((ext_vector_type(4)));
typedef unsigned u32x2 __attribute__((ext_vector_type(2)));
typedef float f32x2_t __attribute__((ext_vector_type(2)));
typedef __bf16 bf16x2_t __attribute__((ext_vector_type(2)));

constexpr size_t OFF_GU1 = 0, OFF_D1 = OFF_GU1 + (size_t)2 * FF * DM, OFF_IN = OFF_D1 + (size_t)DM * FF, OFF_OUT = OFF_IN + (size_t)NIN * DM,
                 OFF_GU2 = OFF_OUT + (size_t)DM * DM, OFF_D2 = OFF_GU2 + (size_t)2 * FF * DM, LAYER_EL = OFF_D2 + (size_t)DM * FF;
constexpr size_t MiB = 1u << 20;
constexpr size_t WS_W = 0, WS_XB = 80 * MiB, WS_SS = 112 * MiB, WS_R = 114 * MiB, WS_HB = WS_R, WS_PROJ = WS_R, WS_MIX = WS_R + 72 * MiB, WS_CTL = 218 * MiB, CTL_BYTES = 65536, WS_END = 219 * MiB;
static_assert(2 * LAYER_EL * 2 <= WS_XB, "weights fit");
static_assert(WS_HB + (size_t)M * FF * 2 <= WS_END && WS_PROJ + (size_t)M * NIN * 2 <= WS_MIX && WS_MIX + (size_t)M * DM * 2 <= WS_CTL && WS_CTL + CTL_BYTES <= WS_END, "ws map");
constexpr int LDS_BYTES = 147456;
constexpr int NPHASE = 16;

struct Args { const float* in[19]; float* out; unsigned char* ws; int ph_lo, ph_hi; };

__device__ __forceinline__ int tid_opaque() { int t = threadIdx.x; asm volatile("" : "+v"(t)); return t; }
__device__ __forceinline__ unsigned cvtpk(float lo, float hi) { f32x2_t v = {lo, hi}; bf16x2_t b = __builtin_convertvector(v, bf16x2_t); return __builtin_bit_cast(unsigned, b); }
__device__ __forceinline__ float wave_sum(float v) {
#pragma unroll
    for (int o = 1; o < 64; o <<= 1) v += __shfl_xor(v, o);
    return v;
}
__device__ __forceinline__ float xrow16_sum(float x) {
    auto s = __builtin_amdgcn_permlane16_swap(__float_as_uint(x), __float_as_uint(x), false, false);
    x = __uint_as_float(s[0]) + __uint_as_float(s[1]);
    auto t = __builtin_amdgcn_permlane32_swap(__float_as_uint(x), __float_as_uint(x), false, false);
    return __uint_as_float(t[0]) + __uint_as_float(t[1]);
}
__device__ __forceinline__ float row_rstd(const float* __restrict__ ss, int row, int fq) {
    const f32x4 v = *(const f32x4*)(ss + (size_t)row * 16 + 4 * fq);
    float s = (v[0] + v[1]) + (v[2] + v[3]);
    s += __shfl_xor(s, 16); s += __shfl_xor(s, 32);
    return __builtin_amdgcn_rsqf(s * (1.0f / DM) + RMS_EPS);
}

__device__ __forceinline__ void rows_rstd(const float* __restrict__ ss, int row0, int fq, float (&r)[8]) {
    f32x4 v[8];
#pragma unroll
    for (int i = 0; i < 8; ++i) v[i] = *(const f32x4*)(ss + (size_t)(row0 + (i >> 2) * 128 + (i & 3) * 16) * 16 + 4 * fq);
#pragma unroll
    for (int i = 0; i < 8; ++i) r[i] = (v[i][0] + v[i][1]) + (v[i][2] + v[i][3]);
#pragma unroll
    for (int i = 0; i < 8; ++i) r[i] = xrow16_sum(r[i]);
#pragma unroll
    for (int i = 0; i < 8; ++i) r[i] = __builtin_amdgcn_rsqf(r[i] * (1.0f / DM) + RMS_EPS);
}

struct EpiSwiGLU {
    static constexpr bool PERM = true, AFTER_DRAIN = false;
    bf16_t* H; const float* ss;
    __device__ __forceinline__ void operator()(const f32x4 (&acc)[2][2][4][2], const pg8::Unit& u, int wr, int wc, int fr, int fq) const {
        const int row0 = u.pm * 256 + wr * 64 + fr, col0 = u.pn * 128 + wc * 32 + 8 * fq;
        float rr[8]; rows_rstd(ss, row0, fq, rr);
#pragma unroll
        for (int ai = 0; ai < 2; ++ai)
#pragma unroll
            for (int m = 0; m < 4; ++m) {
                const int row = row0 + ai * 128 + m * 16;
                const float r = rr[ai * 4 + m];
                unsigned o[4];
#pragma unroll
                for (int n = 0; n < 2; ++n) {
                    float hv[4];
#pragma unroll
                    for (int i = 0; i < 4; ++i) {
                        const float g = acc[ai][0][m][n][i] * r, up = acc[ai][1][m][n][i] * r;
                        const float sg = g * __builtin_amdgcn_rcpf(1.0f + __builtin_amdgcn_exp2f(-g * LOG2E));
                        hv[i] = sg * up;
                    }
                    o[2 * n] = cvtpk(hv[0], hv[1]); o[2 * n + 1] = cvtpk(hv[2], hv[3]);
                }
                *(u32x4*)(H + (size_t)row * FF + col0) = (u32x4){o[0], o[1], o[2], o[3]};
            }
    }
};
struct EpiResid {
    static constexpr bool PERM = true, AFTER_DRAIN = false;
    const float* xin; float* xout; bf16_t* xb; float* ss; float scale; int last;
    __device__ __forceinline__ void operator()(const f32x4 (&acc)[2][2][4][2], const pg8::Unit& u, int wr, int wc, int fr, int fq) const {
        const int row0 = u.pm * 256 + wr * 64 + fr, col0 = u.pn * 256 + wc * 32 + 8 * fq;
#pragma unroll
        for (int ai = 0; ai < 2; ++ai) {
            f32x4 xa[4][2][2];
#pragma unroll
            for (int m = 0; m < 4; ++m)
#pragma unroll
                for (int bj = 0; bj < 2; ++bj) { const size_t idx = (size_t)(row0 + ai * 128 + m * 16) * DM + col0 + bj * 128;
                    xa[m][bj][0] = *(const f32x4*)(xin + idx); xa[m][bj][1] = *(const f32x4*)(xin + idx + 4); }
#pragma unroll
            for (int m = 0; m < 4; ++m) {
                const int row = row0 + ai * 128 + m * 16;
                float sq = 0.f;
#pragma unroll
                for (int bj = 0; bj < 2; ++bj) {
                    const size_t idx = (size_t)row * DM + col0 + bj * 128;
                    const f32x4 a0 = xa[m][bj][0], a1 = xa[m][bj][1];
                    const f32x4 v0 = a0 + acc[ai][bj][m][0] * scale, v1 = a1 + acc[ai][bj][m][1] * scale;
                    if (!last) { *(f32x4*)(xout + idx) = v0; *(f32x4*)(xout + idx + 4) = v1; }
                    *(u32x4*)(xb + idx) = (u32x4){cvtpk(v0[0], v0[1]), cvtpk(v0[2], v0[3]), cvtpk(v1[0], v1[1]), cvtpk(v1[2], v1[3])};
                    sq += (v0[0] * v0[0] + v0[1] * v0[1]) + (v0[2] * v0[2] + v0[3] * v0[3]) + (v1[0] * v1[0] + v1[1] * v1[1]) + (v1[2] * v1[2] + v1[3] * v1[3]);
                }
                sq = xrow16_sum(sq);
                if (fq == 0) ss[(size_t)row * 16 + u.pn * 4 + wc] = sq;
            }
        }
    }
};
struct EpiProj {
    static constexpr bool PERM = true, AFTER_DRAIN = false;
    bf16_t* P; const float* ss;
    __device__ __forceinline__ void operator()(const f32x4 (&acc)[2][2][4][2], const pg8::Unit& u, int wr, int wc, int fr, int fq) const {
        const int row0 = u.pm * 256 + wr * 64 + fr, col0 = u.pn * 256 + wc * 32 + 8 * fq;
        const float cs = (u.pn < 2 || u.pn == 3 || u.pn == 4) ? C2 : 1.0f;
        float rr[8]; rows_rstd(ss, row0, fq, rr);
#pragma unroll
        for (int ai = 0; ai < 2; ++ai)
#pragma unroll
            for (int m = 0; m < 4; ++m) {
                const int row = row0 + ai * 128 + m * 16;
                const float r = rr[ai * 4 + m] * cs;
#pragma unroll
                for (int bj = 0; bj < 2; ++bj) {
                    const f32x4 v0 = acc[ai][bj][m][0] * r, v1 = acc[ai][bj][m][1] * r;
                    *(u32x4*)(P + (size_t)row * NIN + col0 + bj * 128) = (u32x4){cvtpk(v0[0], v0[1]), cvtpk(v0[2], v0[3]), cvtpk(v1[0], v1[1]), cvtpk(v1[2], v1[3])};
                }
            }
    }
};

__device__ __forceinline__ void transpose_item(const float* __restrict__ W, int K, int N, const float* __restrict__ gain, bf16_t* __restrict__ WT, int mode, LAS float* scr, int item, int lane) {
    const int nblk = N / 32, kb = item / nblk, nb = item % nblk, k0 = 64 * kb, n0 = 32 * nb;
    float wv[32];
    const float* wp = W + (size_t)(k0 + (lane >> 5)) * N + n0 + (lane & 31);
#pragma unroll
    for (int i = 0; i < 32; ++i) wv[i] = __builtin_nontemporal_load(wp + (size_t)(2 * i) * N);
#pragma unroll
    for (int i = 0; i < 32; ++i) { const int kk = 2 * i + (lane >> 5); scr[kk * 33 + (lane & 31)] = wv[i]; }
    asm volatile("s_waitcnt lgkmcnt(0)" ::: "memory");
    const int rb = mode == 0 ? n0 : ((n0 >> 7) * 256 + (n0 & 127) + (mode == 2 ? 128 : 0));
    const int c = lane & 7;
    f32x4 g0 = {1.f, 1.f, 1.f, 1.f}, g1 = g0;
    if (gain) { g0 = *(const f32x4*)(gain + k0 + 8 * c); g1 = *(const f32x4*)(gain + k0 + 8 * c + 4); }
#pragma unroll
    for (int j = 0; j < 4; ++j) { const int n = (lane >> 3) + 8 * j; const LAS float* s = scr + (8 * c) * 33 + n;
        u32x4 o; o.x = cvtpk(s[0 * 33] * g0[0], s[1 * 33] * g0[1]); o.y = cvtpk(s[2 * 33] * g0[2], s[3 * 33] * g0[3]); o.z = cvtpk(s[4 * 33] * g1[0], s[5 * 33] * g1[1]); o.w = cvtpk(s[6 * 33] * g1[2], s[7 * 33] * g1[3]);
        *(u32x4*)(WT + (size_t)(rb + n) * K + k0 + 8 * c) = o; }
    asm volatile("s_waitcnt lgkmcnt(0)" ::: "memory");
}
constexpr int I_GU = (DM / 64) * (FF / 32), I_D = (FF / 64) * (DM / 32), I_IN = (DM / 64) * (NIN / 32), I_OUT = (DM / 64) * (DM / 32);
constexpr int ITEMS_L = 4 * I_GU + 2 * I_D + I_IN + I_OUT;

__device__ __forceinline__ void convert_items(LAS unsigned char* lds, const Args& a, int it0, int it1, int gw, int NGW) {
    const int tid = tid_opaque(), lane = tid & 63, wave = __builtin_amdgcn_readfirstlane(tid >> 6);
    LAS float* scr = (LAS float*)(lds + wave * 16384);
    bf16_t* wbase = (bf16_t*)(a.ws + WS_W);
    for (int it = it0 + gw; it < it1; it += NGW) {
        const int l = it / ITEMS_L; int r = it % ITEMS_L;
        bf16_t* wl = wbase + (size_t)l * LAYER_EL;
        const float* W; const float* gain = nullptr; bf16_t* dst; int K = DM, N = FF, mode = 0;
        if (r < I_GU)                { W = a.in[2] + (size_t)l * DM * FF; gain = a.in[1] + l * DM; dst = wl + OFF_GU1; mode = 1; }
        else if ((r -= I_GU) < I_GU) { W = a.in[3] + (size_t)l * DM * FF; gain = a.in[1] + l * DM; dst = wl + OFF_GU1; mode = 2; }
        else if ((r -= I_GU) < I_D)  { W = a.in[4] + (size_t)l * FF * DM; dst = wl + OFF_D1; K = FF; N = DM; }
        else if ((r -= I_D) < I_IN)  { W = a.in[6] + (size_t)l * DM * NIN; gain = a.in[5] + l * DM; dst = wl + OFF_IN; N = NIN; }
        else if ((r -= I_IN) < I_OUT){ W = a.in[13] + (size_t)l * DM * DM; dst = wl + OFF_OUT; N = DM; }
        else if ((r -= I_OUT) < I_GU){ W = a.in[15] + (size_t)l * DM * FF; gain = a.in[14] + l * DM; dst = wl + OFF_GU2; mode = 1; }
        else if ((r -= I_GU) < I_GU) { W = a.in[16] + (size_t)l * DM * FF; gain = a.in[14] + l * DM; dst = wl + OFF_GU2; mode = 2; }
        else { r -= I_GU;              W = a.in[17] + (size_t)l * FF * DM; dst = wl + OFF_D2; K = FF; N = DM; }
        transpose_item(W, K, N, gain, dst, mode, scr, r, lane);
    }
}
__device__ __forceinline__ void filler_items(LAS unsigned char* lds, const Args& a, int it0, int it1, int nwg, int G, int c) {
    const int r = nwg % G;
    const int n_idle = r == 0 ? G : G - r, rank = r == 0 ? c : c - r;
    if (rank < 0) return;
    const int wave = __builtin_amdgcn_readfirstlane(tid_opaque() >> 6);
    convert_items(lds, a, it0, it1, rank * 8 + wave, n_idle * 8);
}
constexpr int IT_D1 = 2 * I_GU, IT_GU2 = IT_D1 + I_D + I_IN + I_OUT, IT_IN = IT_D1 + I_D, IT_D2 = IT_GU2 + 2 * I_GU;
__device__ __forceinline__ void prologue_phase(LAS unsigned char* lds, const Args& a, int vcu, int G) {
    const int tid = tid_opaque(), lane = tid & 63, wave = __builtin_amdgcn_readfirstlane(tid >> 6);
    const int gw = vcu * 8 + wave, NGW = G * 8;
    convert_items(lds, a, 0, IT_D1, gw, NGW);
    const float* x = a.in[0]; bf16_t* xb = (bf16_t*)(a.ws + WS_XB); float* ss = (float*)(a.ws + WS_SS);
    for (int row = gw; row < M; row += 4 * NGW) {
        f32x4 v[4][4];
#pragma unroll
        for (int q = 0; q < 4; ++q) { const int rr = row + q * NGW < M ? row + q * NGW : row; const f32x4* xr = (const f32x4*)(x + (size_t)rr * DM) + lane;
#pragma unroll
            for (int j = 0; j < 4; ++j) v[q][j] = __builtin_nontemporal_load(xr + 64 * j); }
#pragma unroll
        for (int q = 0; q < 4; ++q) { const int rr = row + q * NGW; if (rr < M) { u32x2* o = (u32x2*)(xb + (size_t)rr * DM) + lane; float s = 0.f;
#pragma unroll
            for (int j = 0; j < 4; ++j) { const f32x4 t = v[q][j]; s += (t[0] * t[0] + t[1] * t[1]) + (t[2] * t[2] + t[3] * t[3]); o[64 * j] = (u32x2){cvtpk(t[0], t[1]), cvtpk(t[2], t[3])}; }
            s = wave_sum(s);
            if (lane < 16) ss[(size_t)rr * 16 + lane] = lane == 0 ? s : 0.f; } }
    }
}
__device__ __forceinline__ void final_phase(const Args& a, int vcu, int G) {
    const int tid = tid_opaque(), lane = tid & 63, wave = __builtin_amdgcn_readfirstlane(tid >> 6);
    const int gw = vcu * 8 + wave, NGW = G * 8;
    const float* ss = (const float*)(a.ws + WS_SS); const float* gn = a.in[18];
    const f32x4* gr = (const f32x4*)gn + lane;
    f32x4 gv[4];
#pragma unroll
    for (int j = 0; j < 4; ++j) gv[j] = gr[64 * j];
    const bf16_t* xb = (const bf16_t*)(a.ws + WS_XB);
    for (int row = gw; row < M; row += 4 * NGW) {
        u32x2 v[4][4]; float r[4];
#pragma unroll
        for (int q = 0; q < 4; ++q) { const int rr = row + q * NGW < M ? row + q * NGW : row; const u32x2* xr = (const u32x2*)(xb + (size_t)rr * DM) + lane;
#pragma unroll
            for (int j = 0; j < 4; ++j) v[q][j] = xr[64 * j];
            const f32x4* sp = (const f32x4*)(ss + (size_t)rr * 16); float s = 0.f;
#pragma unroll
            for (int j = 0; j < 4; ++j) { const f32x4 t = sp[j]; s += (t[0] + t[1]) + (t[2] + t[3]); }
            r[q] = __builtin_amdgcn_rsqf(s * (1.0f / DM) + RMS_EPS); }
#pragma unroll
        for (int q = 0; q < 4; ++q) { const int rr = row + q * NGW; if (rr < M) { f32x4* xr = (f32x4*)(a.out + (size_t)rr * DM) + lane;
#pragma unroll
            for (int j = 0; j < 4; ++j) { const u32x2 t = v[q][j];
                const f32x4 xf = {__builtin_bit_cast(float, t[0] << 16), __builtin_bit_cast(float, t[0] & 0xffff0000u), __builtin_bit_cast(float, t[1] << 16), __builtin_bit_cast(float, t[1] & 0xffff0000u)};
                __builtin_nontemporal_store(xf * r[q] * gv[j], xr + 64 * j); } } }
    }
}

__device__ __forceinline__ int img_off(int row, int ch) { return 256 * row + 16 * (ch ^ (((row & 3) << 2) | ((row >> 2) & 3))); }
__device__ __forceinline__ s16x4 vtr(const LAS unsigned char* p) { return __builtin_bit_cast(s16x4, __builtin_amdgcn_ds_read_tr16_b64_v4i16((LAS v4i16_t*)p)); }

__device__ __forceinline__ void pack_p(const f32x16& s0, const f32x16& s1, float delta, bf16x8 (&pf)[4], float& rs) {
    float acc = 0.f;
#pragma unroll
    for (int sp = 0; sp < 4; ++sp) {
        float e[8];
#pragma unroll
        for (int j = 0; j < 8; ++j) { e[j] = __builtin_amdgcn_exp2f((sp < 2 ? s0[8 * sp + j] : s1[8 * (sp - 2) + j]) - delta); acc += e[j]; }
        const u32x4 t = {cvtpk(e[0], e[1]), cvtpk(e[2], e[3]), cvtpk(e[4], e[5]), cvtpk(e[6], e[7])};
        pf[sp] = __builtin_bit_cast(bf16x8, t);
    }
    rs = acc;
}
template <int MODE>
__device__ __forceinline__ void attn_unit(LAS unsigned char* lds, const bf16_t* __restrict__ proj, bf16_t* __restrict__ mix, int b, int qblk, int hj,
                                          const float* __restrict__ sink, const float* __restrict__ subln, float lam, float post) {
    constexpr int NEB = MODE ? 4 : 2;
    const int tid = tid_opaque(), lane = tid & 63, wid = __builtin_amdgcn_readfirstlane(tid >> 6);
    const int c = wid >> 2, w = wid & 3, hi = lane >> 5, l31 = lane & 31;
    int qcol, kcol, vcol, ocol, eb0; float slope2, m, l;
    if (MODE == 0) { const int hq = 4 * c + hj; qcol = hq * 64; kcol = 512; vcol = 640; ocol = hq * 64; eb0 = 2 * c;
        slope2 = __builtin_amdgcn_exp2f(-(float)(hq + 1)) * LOG2E; m = sink[hq] * LOG2E; l = hi ? 0.f : 1.f; }
    else { qcol = 768 + hj * 128 + c * 64; kcol = 1280 + hj * 128; vcol = 1792 + hj * 128; ocol = 512 + hj * 128; eb0 = 0;
        slope2 = __builtin_amdgcn_exp2f(-2.0f * (float)(hj + 1)) * LOG2E; m = 0.f; l = 0.f; }
    const size_t rowbase = (size_t)b * SEQ;
    const int qpos = qblk * 128 + w * 32 + l31;
    bf16x8 qf[4];
    { const bf16_t* qp = proj + (rowbase + qpos) * NIN + qcol + 8 * hi;
#pragma unroll
      for (int ks = 0; ks < 4; ++ks) qf[ks] = *(const bf16x8*)(qp + 16 * ks); }
    int kt0 = 0, kt1 = SEQ / 64;
    if (MODE == 0) { kt0 = qblk * 2 - 2 < 0 ? 0 : qblk * 2 - 2; kt1 = qblk * 2 + 4 > SEQ / 64 ? SEQ / 64 : qblk * 2 + 4; }
    const int nt = kt1 - kt0, ktbase = MODE ? 2 * qblk : kt0;
#define KT_OF(it) (MODE ? ((ktbase + (it)) & (SEQ / 64 - 1)) : (ktbase + (it)))
    const int qmin = qblk * 128 + w * 32;
    bool first = (MODE == 1);
    int kaddr[4];
#pragma unroll
    for (int ks = 0; ks < 4; ++ks) kaddr[ks] = img_off(l31, 8 * c + 2 * ks + hi);
    const int g = lane >> 4, q4 = (lane >> 2) & 3, p = lane & 3;
    int vaddr[NEB][2];
#pragma unroll
    for (int e = 0; e < NEB; ++e)
#pragma unroll
        for (int sec = 0; sec < 2; ++sec) vaddr[e][sec] = 65536 + img_off(4 * hi + q4 + 8 * sec, 4 * (eb0 + e) + 2 * (g & 1) + (p >> 1)) + 8 * (p & 1);
    const int prow = 4 * wid + (lane >> 4), pch = (lane & 15) ^ (((lane >> 4) << 2) | (wid & 3));
    const bf16_t* kg = proj + (rowbase + prow) * NIN + kcol + pch * 8;
    const bf16_t* vg = proj + (rowbase + prow) * NIN + vcol + pch * 8;
    const unsigned pdst = (unsigned)wid * 1024u;
#define STAGE_TILE(kt_, buf_, vbuf_) do { const size_t go_ = (size_t)(kt_) * 64 * NIN; LAS unsigned char* kb_ = lds + (buf_) * 16384 + pdst; LAS unsigned char* vb_ = lds + 65536 + (vbuf_) * 16384 + pdst; \
        __builtin_amdgcn_global_load_lds((const unsigned*)(kg + go_), (LAS unsigned*)kb_, 16, 0, 0); \
        __builtin_amdgcn_global_load_lds((const unsigned*)(kg + go_ + (size_t)32 * NIN), (LAS unsigned*)(kb_ + 8192), 16, 0, 0); \
        __builtin_amdgcn_global_load_lds((const unsigned*)(vg + go_), (LAS unsigned*)vb_, 16, 0, 0); \
        __builtin_amdgcn_global_load_lds((const unsigned*)(vg + go_ + (size_t)32 * NIN), (LAS unsigned*)(vb_ + 8192), 16, 0, 0); } while (0)
    f32x16 O[NEB];
#pragma unroll
    for (int e = 0; e < NEB; ++e)
#pragma unroll
        for (int r = 0; r < 16; ++r) O[e][r] = 0.f;

#define PACK_H(s_, delta_, rs_) do { float acc_ = 0.f; _Pragma("unroll") for (int sp = 0; sp < 2; ++sp) { float e_[8]; \
        _Pragma("unroll") for (int j = 0; j < 8; ++j) { e_[j] = __builtin_amdgcn_exp2f(s_[8 * sp + j] - (delta_)); acc_ += e_[j]; } \
        const u32x4 t_ = {cvtpk(e_[0], e_[1]), cvtpk(e_[2], e_[3]), cvtpk(e_[4], e_[5]), cvtpk(e_[6], e_[7])}; pfh[sp] = __builtin_bit_cast(bf16x8, t_); } rs_ = acc_; } while (0)
#define SOFTMAX_H(cur_, oth_) do { float rs_; PACK_H(cur_, 0.0f, rs_); \
        if (first || __builtin_amdgcn_ballot_w64(!(rs_ <= 16384.0f)) != 0ull) { \
            float mx_ = cur_[0]; \
            _Pragma("unroll") for (int r = 1; r < 16; ++r) mx_ = __builtin_fmaxf(mx_, cur_[r]); \
            mx_ = __builtin_fmaxf(mx_, __shfl_xor(mx_, 32)); \
            const float delta_ = first ? mx_ : __builtin_fmaxf(mx_, 0.0f); \
            const float alpha_ = __builtin_amdgcn_exp2f(-delta_); \
            m += delta_; l *= alpha_; \
            _Pragma("unroll") for (int e = 0; e < NEB; ++e) _Pragma("unroll") for (int r = 0; r < 16; ++r) O[e][r] *= alpha_; \
            _Pragma("unroll") for (int r = 0; r < 16; ++r) oth_[r] -= delta_; \
            PACK_H(cur_, delta_, rs_); \
            first = false; \
        } \
        l += rs_; } while (0)
#define HALF_STEP(cur_, oth_, ks_, kh_, vs_, vh_) do { \
        bf16x8 vf_[2 * NEB]; bf16x8 kf_[4]; \
        { const int vo_ = (vs_) * 16384 + 8192 * (vh_); \
          _Pragma("unroll") for (int sp = 0; sp < 2; ++sp) _Pragma("unroll") for (int e = 0; e < NEB; ++e) { \
            const s16x4 lo = vtr(lds + vaddr[e][0] + vo_ + 4096 * sp), hh = vtr(lds + vaddr[e][1] + vo_ + 4096 * sp); \
            vf_[sp * NEB + e] = (bf16x8){lo[0], lo[1], lo[2], lo[3], hh[0], hh[1], hh[2], hh[3]}; } \
          const int ko_ = (ks_) * 16384 + 8192 * (kh_); \
          _Pragma("unroll") for (int ks = 0; ks < 4; ++ks) kf_[ks] = *(const LAS bf16x8*)(lds + kaddr[ks] + ko_); } \
        __builtin_amdgcn_sched_barrier(0); \
        _Pragma("unroll") for (int ks = 0; ks < 4; ++ks) oth_ = __builtin_amdgcn_mfma_f32_32x32x16_bf16(kf_[ks], qf[ks], oth_, 0, 0, 0); \
        SOFTMAX_H(cur_, oth_); \
        _Pragma("unroll") for (int sp = 0; sp < 2; ++sp) _Pragma("unroll") for (int e = 0; e < NEB; ++e) O[e] = __builtin_amdgcn_mfma_f32_32x32x16_bf16(vf_[sp * NEB + e], pfh[sp], O[e], 0, 0, 0); \
    } while (0)
#define S_H(s_, slot_, h_) do { const LAS unsigned char* Kb_ = lds + (slot_) * 16384 + 8192 * (h_); bf16x8 kf_[4]; \
        _Pragma("unroll") for (int ks = 0; ks < 4; ++ks) kf_[ks] = *(const LAS bf16x8*)(Kb_ + kaddr[ks]); \
        _Pragma("unroll") for (int ks = 0; ks < 4; ++ks) s_ = __builtin_amdgcn_mfma_f32_32x32x16_bf16(kf_[ks], qf[ks], s_, 0, 0, 0); } while (0)
#define BIAS_H(s_, kt_, h_) do { const int k0_ = (kt_) * 64 + 32 * (h_); const float dq_ = (float)(qpos - k0_ - 4 * hi); \
        if (MODE == 1) { const float sg_ = k0_ < qmin ? slope2 : -slope2; const float base_ = __builtin_fmaf(-slope2, __builtin_fabsf(dq_), -m); \
            _Pragma("unroll") for (int r = 0; r < 16; ++r) { const float cc_ = (float)((r & 3) + 8 * (r >> 2)); s_[r] = __builtin_fmaf(sg_, cc_, base_); } } \
        if (MODE == 0 || k0_ == qmin) { \
            _Pragma("unroll") for (int r = 0; r < 16; ++r) { const float cc_ = (float)((r & 3) + 8 * (r >> 2)); \
                const float d0_ = __builtin_fabsf(dq_ - cc_); float a0_ = __builtin_fmaf(-slope2, d0_, -m); \
                if (MODE == 0) a0_ = d0_ > 128.0f ? -1e30f : a0_; \
                s_[r] = a0_; } } } while (0)
#define ATT_TRIP(it_, sl_) do { \
        if ((it_) + 2 < nt) asm volatile("s_waitcnt vmcnt(4)" ::: "memory"); else asm volatile("s_waitcnt vmcnt(0)" ::: "memory");     \
        __builtin_amdgcn_s_barrier();                                         \
        asm volatile("" ::: "memory"); \
        if ((it_) + 3 < nt) { STAGE_TILE(KT_OF((it_) + 3), ((sl_) + 3) & 3, ((sl_) + 3) & 3); } \
        HALF_STEP(sA, sB, (sl_), 1, (sl_), 0);                                \
        BIAS_H(sA, KT_OF((it_) + 1), 0); \
        HALF_STEP(sB, sA, ((sl_) + 1) & 3, 0, (sl_), 1);                      \
        BIAS_H(sB, KT_OF((it_) + 1), 1); \
    } while (0)
    bf16x8 pfh[2];
    f32x16 sA, sB;
    STAGE_TILE(KT_OF(0), 0, 0); STAGE_TILE(KT_OF(1), 1, 1); STAGE_TILE(KT_OF(2), 2, 2);
    BIAS_H(sA, KT_OF(0), 0);
    BIAS_H(sB, KT_OF(0), 1);
    asm volatile("s_waitcnt vmcnt(8)" ::: "memory");
    __builtin_amdgcn_s_barrier();
    asm volatile("" ::: "memory");
    S_H(sA, 0, 0);
    if (MODE == 1) { for (int it = 0; it < nt; it += 4) { ATT_TRIP(it, 0); ATT_TRIP(it + 1, 1); ATT_TRIP(it + 2, 2); ATT_TRIP(it + 3, 3); } }
    else { for (int it = 0; it < nt; ++it) ATT_TRIP(it, it & 3); }
    __syncthreads();
    const float lt = l + __shfl_xor(l, 32);
    const float inv = 1.0f / lt;
    bf16_t* op = mix + (rowbase + qpos) * DM + ocol + 4 * hi;
    if (MODE == 0) {
#pragma unroll
        for (int e = 0; e < NEB; ++e)
#pragma unroll
            for (int g4 = 0; g4 < 4; ++g4)
                *(u32x2*)(op + 32 * e + 8 * g4) = (u32x2){cvtpk(O[e][4 * g4] * inv, O[e][4 * g4 + 1] * inv), cvtpk(O[e][4 * g4 + 2] * inv, O[e][4 * g4 + 3] * inv)};
    } else {
        LAS float* X = (LAS float*)lds;
        if (c == 1) {
#pragma unroll
            for (int e = 0; e < NEB; ++e)
#pragma unroll
                for (int r = 0; r < 16; ++r) X[((w * 4 + e) * 16 + r) * 64 + lane] = O[e][r] * inv;
        }
        __syncthreads();
        if (c == 0) {
            float sq = 0.f;
#pragma unroll
            for (int e = 0; e < NEB; ++e)
#pragma unroll
                for (int r = 0; r < 16; ++r) { const float v = O[e][r] * inv - lam * X[((w * 4 + e) * 16 + r) * 64 + lane]; O[e][r] = v; sq += v * v; }
            sq += __shfl_xor(sq, 32);
            const float rn = __builtin_amdgcn_rsqf(sq * (1.0f / 128.0f) + RMS_EPS) * post;
#pragma unroll
            for (int e = 0; e < NEB; ++e)
#pragma unroll
                for (int g4 = 0; g4 < 4; ++g4) {
                    const f32x4 gv = *(const f32x4*)(subln + 32 * e + 8 * g4 + 4 * hi);
                    *(u32x2*)(op + 32 * e + 8 * g4) = (u32x2){cvtpk(O[e][4 * g4] * rn * gv[0], O[e][4 * g4 + 1] * rn * gv[1]), cvtpk(O[e][4 * g4 + 2] * rn * gv[2], O[e][4 * g4 + 3] * rn * gv[3])};
                }
        }
    }
    __syncthreads();
}

__device__ __forceinline__ void attn_phase(LAS unsigned char* lds, const Args& a, int layer, int vcu, int G) {
    const bf16_t* proj = (const bf16_t*)(a.ws + WS_PROJ); bf16_t* mix = (bf16_t*)(a.ws + WS_MIX);
    const int lane = tid_opaque() & 63;
    const float a1 = wave_sum(a.in[8][layer * 64 + lane] * a.in[9][layer * 64 + lane]);
    const float a2 = wave_sum(a.in[10][layer * 64 + lane] * a.in[11][layer * 64 + lane]);
    const float lam_init = layer ? 0.35550906759096927f : 0.2f;
    const float lam = __expf(a1) - __expf(a2) + lam_init;
    const float post = 1.0f - lam_init;
    for (int u = vcu; u < BATCH * 4 * (SEQ / 128); u += G) { const int bh = u >> 5, qblk = u & 31;
        attn_unit<1>(lds, proj, mix, bh >> 2, qblk, bh & 3, nullptr, a.in[12] + layer * 128, lam, post); }
    for (int u = vcu; u < BATCH * 4 * (SEQ / 128); u += G) { const int b = u >> 7, rem = u & 127, qblk = rem >> 2, hj = rem & 3;
        attn_unit<0>(lds, proj, mix, b, qblk, hj, a.in[7] + layer * 8, nullptr, 0.f, 0.f); }
}

#define XB_TMO      128
#define XB_XCNT(j)  (256  + 64 * (j))
#define XB_XSUB(j)  (1280 + 64 * (j))
#define XB_XGEN(j)  (2304 + 64 * (j))
#define XB_TOP      3328
#define XB_TOPGEN   3392
#define XCD_BAR_WORDS 3456
#define XB_SPIN_CAP (1u << 18)

__device__ __forceinline__ unsigned xb_ld(unsigned* p)              { return __hip_atomic_load(p, __ATOMIC_RELAXED, __HIP_MEMORY_SCOPE_AGENT); }
__device__ __forceinline__ unsigned xb_add(unsigned* p, unsigned v) { return __hip_atomic_fetch_add(p, v, __ATOMIC_RELAXED, __HIP_MEMORY_SCOPE_AGENT); }
__device__ __forceinline__ unsigned xb_xcc_id() { return (unsigned)__builtin_amdgcn_s_getreg((3 << 11) | 20) & 0xFu; }
#define XB_SPIN(cond, bar) do { unsigned _sp = 0; while (cond) { __builtin_amdgcn_s_sleep(1); \
    if ((++_sp & 255u) == 0u) { if (xb_ld(&(bar)[XB_TMO])) break; if (_sp > XB_SPIN_CAP) { atomicAdd(&(bar)[XB_TMO], 1u); break; } } } } while (0)

struct XcdBarrier {
    unsigned* bar; unsigned x;
    volatile LAS unsigned* st;
};

__device__ __forceinline__ XcdBarrier xcd_barrier_post(unsigned* bar, volatile LAS unsigned* st) {
    XcdBarrier b; b.bar = bar; b.x = xb_xcc_id(); b.st = st;
    if (threadIdx.x == 0) (void)xb_add(&bar[XB_XCNT(b.x)], 1u);
    return b;
}
__device__ __forceinline__ void xcd_barrier_complete(unsigned* bar, unsigned x, unsigned& nloc, unsigned& nx) {
    const unsigned G = gridDim.x * gridDim.y * gridDim.z;
    unsigned sum, cnt, mine, sp = 0u;
    for (;;) {
        sum = 0u; cnt = 0u; mine = 0u;
#pragma unroll
        for (unsigned j = 0; j < 16; ++j) { const unsigned c = xb_ld(&bar[XB_XCNT(j)]); sum += c; cnt += (c > 0u) ? 1u : 0u; mine = (j == x) ? c : mine; }
        if (sum == G) break;
        __builtin_amdgcn_s_sleep(1);
        if ((++sp & 255u) == 0u) { if (xb_ld(&bar[XB_TMO])) break; if (sp > XB_SPIN_CAP) { atomicAdd(&bar[XB_TMO], 1u); break; } }
    }
    nloc = mine > 0u ? mine : 1u; nx = cnt > 0u ? cnt : 1u;
}

__device__ __forceinline__ void xcd_barrier(const XcdBarrier& b) {
    asm volatile("s_waitcnt vmcnt(0)" ::: "memory");
    __syncthreads();
    if (threadIdx.x == 0) {
        unsigned* bar = b.bar;
        __builtin_amdgcn_s_waitcnt(0);
        unsigned nloc = b.st[0], nx = b.st[1];
        if (nloc == 0u) { xcd_barrier_complete(bar, b.x, nloc, nx); b.st[0] = nloc; b.st[1] = nx; }
        const unsigned old = xb_add(&bar[XB_XSUB(b.x)], 1u);
        const unsigned gen = old / nloc;
        if (old + 1u == (gen + 1u) * nloc) {
            __builtin_amdgcn_fence(__ATOMIC_RELEASE, "agent");
            asm volatile("s_waitcnt vmcnt(0)" ::: "memory");
            const unsigned og = xb_add(&bar[XB_TOP], 1u);
            const unsigned tg = og / nx;
            if (og + 1u == (tg + 1u) * nx) xb_add(&bar[XB_TOPGEN], 1u);
            else XB_SPIN(xb_ld(&bar[XB_TOPGEN]) == tg, bar);
            __builtin_amdgcn_fence(__ATOMIC_ACQUIRE, "agent");
            xb_add(&bar[XB_XGEN(b.x)], 1u);
            asm volatile("s_waitcnt vmcnt(0)" ::: "memory");
        } else {
            XB_SPIN(xb_ld(&bar[XB_XGEN(b.x)]) == gen, bar);
            __builtin_amdgcn_fence(__ATOMIC_ACQUIRE, "agent");
            asm volatile("s_waitcnt vmcnt(0)" ::: "memory");
        }
    }
    __syncthreads();
}

__global__ void __launch_bounds__(512, 2) fwd_kernel(Args a0) {
    extern __shared__ __attribute__((aligned(16))) unsigned char lds_raw[];
    LAS unsigned char* lds = (LAS unsigned char*)lds_raw;
    const int G = gridDim.x, bx = blockIdx.x;
    const int vcu = (G % 8 == 0) ? (bx % 8) * (G / 8) + bx / 8 : bx;
    const int ph_lo = a0.ph_lo, ph_hi = a0.ph_hi;
    volatile LAS unsigned* st = (volatile LAS unsigned*)(lds + LDS_BYTES - 64);
    if (threadIdx.x < 16) st[threadIdx.x] = 0u;
    __syncthreads();
    XcdBarrier bar = xcd_barrier_post((unsigned*)(a0.ws + WS_CTL), st);
    for (int ph = ph_lo; ph < ph_hi; ++ph) {
        auto ap4 = __builtin_amdgcn_kernarg_segment_ptr();
        asm volatile("" : "+s"(ap4));
        const Args& a = *(const Args*)ap4;
        bf16_t* xb = (bf16_t*)(a.ws + WS_XB); float* ss = (float*)(a.ws + WS_SS); bf16_t* hb = (bf16_t*)(a.ws + WS_HB);
        bf16_t* proj = (bf16_t*)(a.ws + WS_PROJ); bf16_t* mix = (bf16_t*)(a.ws + WS_MIX);
        if (ph == 0) prologue_phase(lds, a, vcu, G);
        else if (ph == NPHASE - 1) final_phase(a, vcu, G);
        else {
            const int layer = (ph - 1) / 7, k = (ph - 1) % 7;
            const bf16_t* wl = (const bf16_t*)(a.ws + WS_W) + (size_t)layer * LAYER_EL;
            if (k == 0 || k == 5) {
                pg8::Gemm g{xb, wl + (k == 0 ? OFF_GU1 : OFF_GU2), M, 2 * FF, DM}; pg8::StaticOrder S; S.init(M, 2 * FF, G, bx);
                EpiSwiGLU E{hb, ss};
                pg8::gemm_phase<EpiSwiGLU, pg8::StaticOrder, true, true>(lds, g, S, E);
                {
                    const int f0 = layer == 0 ? (k == 0 ? IT_D1 : ITEMS_L) : (k == 0 ? ITEMS_L + IT_IN + I_IN : 0);
                    const int f1 = layer == 0 ? (k == 0 ? IT_GU2 : ITEMS_L + IT_IN + I_IN) : (k == 0 ? ITEMS_L + IT_D2 : 0);
                    if (f1 > f0) filler_items(lds, a, f0, f1, (M / 256) * (2 * FF / 256), G, bx);
                }
            } else if (k == 1 || k == 6 || k == 4) {
                const bool wo = (k == 4);
                pg8::Gemm g{wo ? mix : hb, wl + (k == 1 ? OFF_D1 : (k == 6 ? OFF_D2 : OFF_OUT)), M, DM, wo ? DM : FF}; pg8::StaticOrder S; S.init(M, DM, G, bx);
                EpiResid E{(layer == 0 && k == 1) ? a.in[0] : a.out, a.out, xb, ss, wo ? 1.0f : 0.5f, (layer == 1 && k == 6) ? 1 : 0};
                pg8::gemm_phase<EpiResid, pg8::StaticOrder, true, true>(lds, g, S, E);
            } else if (k == 2) {
                pg8::Gemm g{xb, wl + OFF_IN, M, NIN, DM}; pg8::StaticOrder S; S.init(M, NIN, G, bx);
                EpiProj E{proj, ss};
                pg8::gemm_phase<EpiProj, pg8::StaticOrder, true, true>(lds, g, S, E);
                filler_items(lds, a, layer == 0 ? IT_GU2 : ITEMS_L + IT_D2, layer == 0 ? ITEMS_L : 2 * ITEMS_L, (M / 256) * (NIN / 256), G, bx);
            } else {
                attn_phase(lds, a, layer, vcu, G);
            }
        }
        if (ph + 1 < ph_hi) {
            if (ph_lo < 0) cg::this_grid().sync();
            xcd_barrier(bar);
        }
    }
}

#ifndef MK_PER_PHASE
#define MK_PER_PHASE 0
#endif
extern "C" void kernel_launch(void* const* d_in, const int* in_sizes, int n_in, void* d_out, int out_size, void* d_ws, size_t ws_size, hipStream_t stream) {
    static int grid = 0;
    if (grid == 0) {
        if (n_in != 19 || in_sizes[0] != M * DM || out_size != M * DM || ws_size < WS_END) { fprintf(stderr, "kernel_launch: unexpected shapes (n_in %d, in0 %d, out %d, ws %zu)\n", n_in, n_in > 0 ? in_sizes[0] : -1, out_size, ws_size); grid = -1; return; }
        int dev = 0, cus = 0, per_cu = 0;
        if (hipGetDevice(&dev) != hipSuccess || hipDeviceGetAttribute(&cus, hipDeviceAttributeMultiprocessorCount, dev) != hipSuccess) { grid = -1; return; }
        if (hipFuncSetAttribute((const void*)fwd_kernel, hipFuncAttributeMaxDynamicSharedMemorySize, LDS_BYTES) != hipSuccess) { fprintf(stderr, "kernel_launch: hipFuncSetAttribute failed\n"); grid = -1; return; }
        if (hipOccupancyMaxActiveBlocksPerMultiprocessor(&per_cu, (const void*)fwd_kernel, 512, LDS_BYTES) != hipSuccess || per_cu < 1) { fprintf(stderr, "kernel_launch: occupancy query gave %d\n", per_cu); per_cu = 1; }
        (void)hipGetLastError();
        grid = cus;
    }
    if (grid < 0) return;
    Args a{};
    for (int i = 0; i < 19; ++i) a.in[i] = (const float*)d_in[i];
    a.out = (float*)d_out; a.ws = (unsigned char*)d_ws;
    if (hipMemsetAsync((char*)d_ws + WS_CTL, 0, CTL_BYTES, stream) != hipSuccess) { fprintf(stderr, "kernel_launch: memset of the barrier words failed\n"); return; }
#if MK_PER_PHASE
    for (int ph = 0; ph < NPHASE; ++ph) { a.ph_lo = ph; a.ph_hi = ph + 1; hipLaunchKernelGGL(fwd_kernel, dim3(grid), dim3(512), LDS_BYTES, stream, a); }
#else
    a.ph_lo = 0; a.ph_hi = NPHASE;
    void* kargs[] = {&a};
    const hipError_t e = hipLaunchCooperativeKernel((const void*)fwd_kernel, dim3(grid), dim3(512), kargs, LDS_BYTES, stream);
    if (e != hipSuccess) fprintf(stderr, "kernel_launch: cooperative launch failed: %s (grid %d)\n", hipGetErrorString(e), grid);
#endif
}
```
